# Optimizing an MI355X kernel written in HIP

```python
import math
import jax, jax.numpy as jnp
from jax import lax
import numpy as np

D_MODEL = 2048
BATCH = 8
SEQ = 2048
DEPTH = 4

CTX_LEN = 256
GRID_W = 64
N_MIXERS = 2
EPS = 1e-6
DA_HEADS = 8
DA_QK_DIM = 128
DA_V_DIM = 2 * DA_QK_DIM
DA_QK_W = DA_HEADS * 2 * DA_QK_DIM
DA_V_W = DA_HEADS * DA_V_DIM
ROPE_BASE = 10000.0
Q_BLOCK = 128
GDN_QK_HEADS = 16
GDN_V_HEADS = 32
GDN_QK_DIM = 128
GDN_V_DIM = 128
GDN_QK_W = GDN_QK_HEADS * GDN_QK_DIM
GDN_V_W = GDN_V_HEADS * GDN_V_DIM
GDN_QKV_W = 2 * GDN_QK_W + GDN_V_W
GDN_IN_W = GDN_QKV_W + GDN_V_W + 4 * GDN_V_HEADS
GDN_CONV = 5
GDN_CHUNK = 64
D_FF = 5504
FFN_CONV = 3
N_DA_LAYERS = (DEPTH + 1) // 2
N_GDN_LAYERS = DEPTH // 2

kernel_name = 'hybrid_diffattn_gdeltanet_convffn_dit'


def rmsnorm(x, w):
    xf = x.astype(jnp.float32)
    y = xf * lax.rsqrt(jnp.mean(xf * xf, axis=-1, keepdims=True) + EPS)
    return (y * w.astype(jnp.float32)).astype(x.dtype)


def l2norm(x):
    xf = x.astype(jnp.float32)
    return (xf * lax.rsqrt(jnp.sum(xf * xf, axis=-1, keepdims=True) + EPS)).astype(x.dtype)


def dwconv_centred(x, w):
    k = w.shape[0]
    p = k // 2
    t = x.shape[1]
    xp = jnp.pad(x, ((0, 0), (p, p), (0, 0)))
    out = xp[:, 0:t] * w[0]
    for j in range(1, k):
        out = out + xp[:, j:j + t] * w[j]
    return out


def axial_rope_tables(t_len, rot_dim):
    t = jnp.arange(t_len, dtype=jnp.int32)
    rows = (t // GRID_W).astype(jnp.float32)
    cols = (t % GRID_W).astype(jnp.float32)
    n_freq = rot_dim // 4
    inv_freq = ROPE_BASE ** (-jnp.arange(n_freq, dtype=jnp.float32) / n_freq)
    ang = jnp.stack([rows[:, None] * inv_freq, cols[:, None] * inv_freq], axis=1)
    return jnp.cos(ang), jnp.sin(ang)


def apply_axial_rope(x, cos, sin):
    shp = x.shape
    xr = x.reshape(shp[:-1] + (2, 2, shp[-1] // 4))
    x1, x2 = xr[..., 0, :], xr[..., 1, :]
    c = cos.astype(x.dtype)
    s = sin.astype(x.dtype)
    out = jnp.stack([x1 * c - x2 * s, x2 * c + x1 * s], axis=-2)
    return out.reshape(shp)


def diff_attend(q, k, v, lam):
    s = jnp.einsum('bhcqd,bhckd->bhcqk', q, k).astype(jnp.float32) * (DA_QK_DIM ** -0.5)
    p = jax.nn.softmax(s, axis=-1)
    a = p[:, :, 0] - lam * p[:, :, 1]
    return jnp.einsum('bhqk,bhkd->bhqd', a.astype(v.dtype), v)


def diff_attention_mixer(h_ctx, h_lat, w_qkv, lam_vecs, head_gain, w_o, lambda_init, cos, sin, with_ctx_out):
    def project(h):
        b, t, _ = h.shape
        q, k, v = jnp.split(h @ w_qkv, [DA_QK_W, 2 * DA_QK_W], axis=-1)
        q = q.reshape(b, t, DA_HEADS, 2, DA_QK_DIM).transpose(0, 2, 3, 1, 4)
        k = k.reshape(b, t, DA_HEADS, 2, DA_QK_DIM).transpose(0, 2, 3, 1, 4)
        v = v.reshape(b, t, DA_HEADS, DA_V_DIM).transpose(0, 2, 1, 3)
        return q, k, v

    lv = lam_vecs.astype(jnp.float32)
    lam = jnp.exp(jnp.sum(lv[0] * lv[1])) - jnp.exp(jnp.sum(lv[2] * lv[3])) + lambda_init
    q_c, k_c, v_c = project(h_ctx)
    q_l, k_l, v_l = project(h_lat)
    q_l = apply_axial_rope(q_l, cos, sin)
    k_l = apply_axial_rope(k_l, cos, sin)
    k_all = jnp.concatenate([k_c, k_l], axis=3)
    v_all = jnp.concatenate([v_c, v_l], axis=2)
    b, h, _, t, d = q_l.shape
    nb = t // Q_BLOCK
    q_blocks = jnp.moveaxis(q_l.reshape(b, h, 2, nb, Q_BLOCK, d), 3, 0)
    o_blocks = lax.map(lambda qb: diff_attend(qb, k_all, v_all, lam), q_blocks)
    o_lat = jnp.moveaxis(o_blocks, 0, 2).reshape(b, h, t, DA_V_DIM)

    def out_proj(o):
        o = rmsnorm(o, head_gain) * (1.0 - lambda_init)
        bb, hh, tt, dv = o.shape
        return o.transpose(0, 2, 1, 3).reshape(bb, tt, hh * dv) @ w_o

    y_lat = out_proj(o_lat)
    y_ctx = out_proj(diff_attend(q_c, k_c, v_c, lam)) if with_ctx_out else None
    return y_ctx, y_lat


def gdn_features(h, w_in, conv_w, a_log, dt_bias):
    b, t, _ = h.shape
    qkv, z, ab = jnp.split(h @ w_in, [GDN_QKV_W, GDN_QKV_W + GDN_V_W], axis=-1)
    qkv = jax.nn.silu(dwconv_centred(qkv, conv_w))
    q, k, v = jnp.split(qkv, [GDN_QK_W, 2 * GDN_QK_W], axis=-1)
    rep = GDN_V_HEADS // GDN_QK_HEADS
    q = jnp.repeat(l2norm(q.reshape(b, t, GDN_QK_HEADS, GDN_QK_DIM)), rep, axis=2) * (GDN_QK_DIM ** -0.5)
    k = jnp.repeat(l2norm(k.reshape(b, t, GDN_QK_HEADS, GDN_QK_DIM)), rep, axis=2)
    v = v.reshape(b, t, GDN_V_HEADS, GDN_V_DIM)
    z = z.reshape(b, t, GDN_V_HEADS, GDN_V_DIM)
    ab = ab.reshape(b, t, 2, 2, GDN_V_HEADS).astype(jnp.float32)
    beta = jax.nn.sigmoid(ab[:, :, :, 0])
    g = -jnp.exp(a_log.astype(jnp.float32)) * jax.nn.softplus(ab[:, :, :, 1] + dt_bias.astype(jnp.float32))
    return q, k, v, z, beta, g


def gated_delta_chunked(q, k, v, beta, g, s0, want_out):
    out_dtype = v.dtype
    b, t, h, dk = k.shape
    dv = v.shape[-1]
    n = t // GDN_CHUNK

    def chunks(a):
        a = a.astype(jnp.float32).reshape((b, n, GDN_CHUNK) + a.shape[2:])
        return jnp.swapaxes(a, 2, 3)

    k, v, beta, g = chunks(k), chunks(v), chunks(beta), chunks(g)
    gam = jnp.cumsum(g, axis=-1)
    idx = jnp.arange(GDN_CHUNK)
    incl = idx[:, None] >= idx[None, :]
    strict = idx[:, None] > idx[None, :]
    decay = jnp.exp(jnp.where(incl, gam[..., :, None] - gam[..., None, :], -jnp.inf))
    kk = jnp.einsum('bnhid,bnhjd->bnhij', k, k)
    a_mat = jnp.where(strict, beta[..., :, None] * kk * decay, 0.0)
    rhs = jnp.concatenate([v * beta[..., None], k * (beta * jnp.exp(gam))[..., None]], axis=-1)
    uw = lax.linalg.triangular_solve(a_mat, rhs, left_side=True, lower=True, unit_diagonal=True)
    u, w = uw[..., :dv], uw[..., dv:]
    k_dec = k * jnp.exp(gam[..., -1:] - gam)[..., None]
    g_last = jnp.exp(gam[..., -1])
    xs = [u, w, k_dec, g_last]
    if want_out:
        q = chunks(q)
        qk = jnp.where(incl, jnp.einsum('bnhid,bnhjd->bnhij', q, k) * decay, 0.0)
        xs = xs + [q * jnp.exp(gam)[..., None], qk]
    xs = [jnp.moveaxis(a, 1, 0) for a in xs]

    def step(state, inp):
        u_c, w_c, kd_c, gl_c = inp[0], inp[1], inp[2], inp[3]
        v_new = u_c - jnp.einsum('bhck,bhkv->bhcv', w_c, state)
        new_state = state * gl_c[..., None, None] + jnp.einsum('bhck,bhcv->bhkv', kd_c, v_new)
        if want_out:
            o = jnp.einsum('bhck,bhkv->bhcv', inp[4], state) + jnp.einsum('bhij,bhjv->bhiv', inp[5], v_new)
            return new_state, o
        return new_state, None

    s_final, o = lax.scan(step, s0, xs)
    if want_out:
        o = jnp.swapaxes(jnp.moveaxis(o, 0, 1), 2, 3).reshape(b, t, h, dv).astype(out_dtype)
    return o, s_final


def gdn_output(o, z, norm_gain, w_o):
    b, t, h, dv = o.shape
    y = rmsnorm(o, norm_gain) * jax.nn.silu(z)
    return y.reshape(b, t, h * dv) @ w_o


def gated_deltanet_mixer(h_ctx, h_lat, w_in, conv_w, a_log, dt_bias, norm_gain, w_o, with_ctx_out):
    q_c, k_c, v_c, z_c, beta_c, g_c = gdn_features(h_ctx, w_in, conv_w, a_log, dt_bias)
    q_l, k_l, v_l, z_l, beta_l, g_l = gdn_features(h_lat, w_in, conv_w, a_log, dt_bias)
    s0 = jnp.zeros((h_lat.shape[0], GDN_V_HEADS, GDN_QK_DIM, GDN_V_DIM), jnp.float32)

    def flip(a):
        return jnp.flip(a, axis=1)

    o_cf, s_cf = gated_delta_chunked(q_c, k_c, v_c, beta_c[:, :, 0], g_c[:, :, 0], s0, with_ctx_out)
    o_cb, s_cb = gated_delta_chunked(flip(q_c), flip(k_c), flip(v_c), flip(beta_c[:, :, 1]), flip(g_c[:, :, 1]), s0, with_ctx_out)
    o_lf, _ = gated_delta_chunked(q_l, k_l, v_l, beta_l[:, :, 0], g_l[:, :, 0], s_cf, True)
    o_lb, _ = gated_delta_chunked(flip(q_l), flip(k_l), flip(v_l), flip(beta_l[:, :, 1]), flip(g_l[:, :, 1]), s_cb, True)
    y_lat = gdn_output(o_lf + flip(o_lb), z_l, norm_gain, w_o)
    y_ctx = gdn_output(o_cf + flip(o_cb), z_c, norm_gain, w_o) if with_ctx_out else None
    return y_ctx, y_lat


def conv_ffn(h, w_up, conv_w, w_down):
    u = dwconv_centred(h @ w_up, conv_w)
    gate, val = jnp.split(u, 2, axis=-1)
    return (jax.nn.silu(gate) * val) @ w_down


def setup_inputs(seed: int = 0) -> dict:
    key = jax.random.key(seed)
    ks = jax.random.split(key, 24)

    def nrm(k, shape, scale):
        return jax.random.normal(k, shape, jnp.float32) * scale

    dt = jnp.exp(jax.random.uniform(ks[15], (N_GDN_LAYERS, 2, GDN_V_HEADS), jnp.float32, math.log(1e-3), math.log(1e-1)))
    return {
        'x': nrm(ks[0], (BATCH, SEQ, D_MODEL), 1.0),
        'c': nrm(ks[1], (BATCH, D_MODEL), 1.0),
        'ctx': nrm(ks[2], (BATCH, CTX_LEN, D_MODEL), 1.0),
        'c_ctx': nrm(ks[3], (D_MODEL,), 1.0),
        'w_mod': nrm(ks[4], (DEPTH, D_MODEL, 6 * D_MODEL), 0.5 * D_MODEL ** -0.5),
        'b_mod': nrm(ks[5], (DEPTH, 6 * D_MODEL), 0.02),
        'norm_mix': 1.0 + nrm(ks[6], (DEPTH, D_MODEL), 0.02),
        'norm_ffn': 1.0 + nrm(ks[7], (DEPTH, D_MODEL), 0.02),
        'da_w_qkv': nrm(ks[8], (N_DA_LAYERS, D_MODEL, 2 * DA_QK_W + DA_V_W), D_MODEL ** -0.5),
        'da_lambda': nrm(ks[9], (N_DA_LAYERS, 4, DA_QK_DIM), 0.1),
        'da_head_gain': 1.0 + nrm(ks[10], (N_DA_LAYERS, DA_V_DIM), 0.02),
        'da_w_o': nrm(ks[11], (N_DA_LAYERS, DA_V_W, D_MODEL), DA_V_W ** -0.5),
        'gdn_w_in': nrm(ks[12], (N_GDN_LAYERS, D_MODEL, GDN_IN_W), D_MODEL ** -0.5),
        'gdn_conv': nrm(ks[13], (N_GDN_LAYERS, GDN_CONV, GDN_QKV_W), GDN_CONV ** -0.5),
        'gdn_a_log': jnp.log(jax.random.uniform(ks[14], (N_GDN_LAYERS, 2, GDN_V_HEADS), jnp.float32, 1.0, 16.0)),
        'gdn_dt_bias': dt + jnp.log(-jnp.expm1(-dt)),
        'gdn_norm_gain': 1.0 + nrm(ks[16], (N_GDN_LAYERS, GDN_V_DIM), 0.02),
        'gdn_w_o': nrm(ks[17], (N_GDN_LAYERS, GDN_V_W, D_MODEL), GDN_V_W ** -0.5),
        'ffn_w_up': nrm(ks[18], (DEPTH, D_MODEL, 2 * D_FF), D_MODEL ** -0.5),
        'ffn_conv': nrm(ks[19], (DEPTH, FFN_CONV, 2 * D_FF), FFN_CONV ** -0.5),
        'ffn_w_down': nrm(ks[20], (DEPTH, D_FF, D_MODEL), D_FF ** -0.5),
        'final_norm': 1.0 + nrm(ks[21], (D_MODEL,), 0.02),
    }


def reference(x, c, ctx, c_ctx, w_mod, b_mod, norm_mix, norm_ffn, da_w_qkv, da_lambda, da_head_gain, da_w_o,
              gdn_w_in, gdn_conv, gdn_a_log, gdn_dt_bias, gdn_norm_gain, gdn_w_o, ffn_w_up, ffn_conv, ffn_w_down,
              final_norm):
    seq = x.shape[1]
    cos, sin = axial_rope_tables(seq, DA_QK_DIM)
    silu_c = jax.nn.silu(c)[:, None, :]
    silu_cc = jax.nn.silu(c_ctx)[None, None, :]
    for i in range(DEPTH):
        last = i == DEPTH - 1
        m_l = jnp.split(silu_c @ w_mod[i] + b_mod[i], 6, axis=-1)
        m_c = jnp.split(silu_cc @ w_mod[i] + b_mod[i], 6, axis=-1)
        h_lat = rmsnorm(x, norm_mix[i]) * (1 + m_l[1]) + m_l[0]
        h_ctx = rmsnorm(ctx, norm_mix[i]) * (1 + m_c[1]) + m_c[0]
        j = i // N_MIXERS
        if i % N_MIXERS == 0:
            lambda_init = 0.8 - 0.6 * math.exp(-0.3 * i)
            y_ctx, y_lat = diff_attention_mixer(h_ctx, h_lat, da_w_qkv[j], da_lambda[j], da_head_gain[j], da_w_o[j],
                                                lambda_init, cos, sin, not last)
        else:
            y_ctx, y_lat = gated_deltanet_mixer(h_ctx, h_lat, gdn_w_in[j], gdn_conv[j], gdn_a_log[j], gdn_dt_bias[j],
                                                gdn_norm_gain[j], gdn_w_o[j], not last)
        x = x + m_l[2] * y_lat
        h_lat = rmsnorm(x, norm_ffn[i]) * (1 + m_l[4]) + m_l[3]
        x = x + m_l[5] * conv_ffn(h_lat, ffn_w_up[i], ffn_conv[i], ffn_w_down[i])
        if not last:
            ctx = ctx + m_c[2] * y_ctx
            h_ctx = rmsnorm(ctx, norm_ffn[i]) * (1 + m_c[4]) + m_c[3]
            ctx = ctx + m_c[5] * conv_ffn(h_ctx, ffn_w_up[i], ffn_conv[i], ffn_w_down[i])
    return rmsnorm(x, final_norm)
```

```cpp
#include <hip/hip_runtime.h>
#include <cstdio>
#include <cstdint>

#ifndef MK_SINGLE
#define MK_SINGLE 1
#endif
#ifndef ATTN_SINGLE
#define ATTN_SINGLE 1
#endif
#ifndef SCAN_NAIVE
#define SCAN_NAIVE 0
#endif

#define LAS __attribute__((address_space(3)))
#define GAS __attribute__((address_space(1)))
typedef unsigned short bf16_t;
typedef short bf16x8 __attribute__((ext_vector_type(8)));
typedef short s16x4 __attribute__((ext_vector_type(4)));
typedef float f32x2 __attribute__((ext_vector_type(2)));
typedef float f32x4 __attribute__((ext_vector_type(4)));
typedef float f32x8 __attribute__((ext_vector_type(8)));
typedef float f32x16 __attribute__((ext_vector_type(16)));
typedef unsigned u32x2 __attribute__((ext_vector_type(2)));
typedef unsigned u32x4 __attribute__((ext_vector_type(4)));
typedef __bf16 bf2_t __attribute__((ext_vector_type(2)));

constexpr int DM = 2048, BATCH = 8, SEQ = 2048, CTXL = 256, DEPTH = 4;
constexpr int NLAT = BATCH * SEQ;
constexpr int NCTX = BATCH * CTXL;
constexpr int NTOK = NLAT + NCTX;
constexpr int DA_H = 8, DA_QKVW = 6144;
constexpr int GDN_QKH = 16, GDN_VH = 32, GDN_QKVW = 8192, GDN_VW = 4096, GDN_INW = 12416, GDN_INW_PAD = 12544;
constexpr int DFF = 5504, DFF2 = 11008;
constexpr int MODW = 6 * DM;
constexpr float EPS = 1e-6f;
constexpr float LAMBDA_INIT0 = 0.2f;
constexpr float LAMBDA_INIT2 = 0.47071301834358414f;

constexpr size_t MiB = 1u << 20;
constexpr size_t WS_CTL = 0, CTL_ZERO_BYTES = 4 * MiB;
constexpr size_t WS_MOD = 1 * MiB;
constexpr size_t WS_ROPE = 3 * MiB;
constexpr size_t WS_LAM = 3 * MiB + 64 * 1024;
constexpr size_t WS_WQKV = 4 * MiB;
constexpr size_t WS_WODA = WS_WQKV + 48 * MiB;
constexpr size_t WS_WIN = WS_WODA + 16 * MiB;
constexpr size_t WS_WOG = WS_WIN + 98 * MiB;
constexpr size_t WS_WUP = WS_WOG + 32 * MiB;
constexpr size_t WS_WDN = WS_WUP + 172 * MiB;
constexpr size_t WS_X = WS_WDN + 86 * MiB;
constexpr size_t WS_H = WS_X + 144 * MiB;
constexpr size_t WS_R = WS_H + 72 * MiB;
constexpr size_t WS_QKV = WS_R;
constexpr size_t WS_DIFF = WS_QKV + 216 * MiB;
constexpr size_t WS_AO = WS_DIFF + 144 * MiB;
constexpr size_t WS_RAW = WS_R;
constexpr size_t WS_OF = WS_R, WS_OB = WS_R + 144 * MiB;
constexpr size_t WS_GEDGE = WS_R;
constexpr size_t WS_Z = WS_RAW + 288 * MiB;
constexpr size_t WS_AB = WS_Z + 144 * MiB;
constexpr size_t WS_QN = WS_AB + 9 * MiB;
constexpr size_t WS_KN = WS_QN + 72 * MiB;
constexpr size_t WS_Y = WS_QN;
constexpr size_t WS_VN = WS_KN + 72 * MiB;
constexpr size_t WS_BETA = WS_VN + 144 * MiB;
constexpr size_t WS_G = WS_BETA + (9 * MiB) / 2;
constexpr size_t WS_EDGE = WS_R;
constexpr size_t WS_U = WS_R;
constexpr size_t WS_ACT = WS_U + 387 * MiB;
constexpr size_t WS_PART = WS_R + 738 * MiB;
constexpr size_t WS_END = WS_PART + 64 * MiB;
static_assert(WS_G + (9 * MiB) / 2 <= WS_END && WS_ACT + 194 * MiB <= WS_END && WS_AO + 72 * MiB <= WS_END, "ws map");
static_assert(WS_END <= (size_t)1536 * MiB, "ws map exceeds 4x the largest input");

constexpr int LDS_BYTES = 160 * 1024;
constexpr int MISC_OFF = LDS_BYTES - 256;

__device__ __forceinline__ unsigned pk_bf16(float lo, float hi) { f32x2 v = {lo, hi}; return __builtin_bit_cast(unsigned, __builtin_convertvector(v, bf2_t)); }
__device__ __forceinline__ float bf_lo(unsigned w) { return __uint_as_float(w << 16); }
__device__ __forceinline__ float bf_hi(unsigned w) { return __uint_as_float(w & 0xffff0000u); }
typedef _Float16 f16x2_t __attribute__((ext_vector_type(2)));
__device__ __forceinline__ float xs_lo(unsigned w) { return (float)__builtin_bit_cast(f16x2_t, w)[0]; }
__device__ __forceinline__ float xs_hi(unsigned w) { return (float)__builtin_bit_cast(f16x2_t, w)[1]; }
__device__ __forceinline__ unsigned pk_xs(float a, float b) { f16x2_t v; v[0] = (_Float16)a; v[1] = (_Float16)b; return __builtin_bit_cast(unsigned, v); }
__device__ __forceinline__ float bf2f(bf16_t b) { return __uint_as_float(((unsigned)b) << 16); }
template <int CTRL> __device__ __forceinline__ float dpp_f(float v) { return __builtin_bit_cast(float, __builtin_amdgcn_update_dpp(0, __builtin_bit_cast(int, v), CTRL, 0xF, 0xF, true)); }
__device__ __forceinline__ float sum16(float v) { v += dpp_f<0xB1>(v); v += dpp_f<0x4E>(v); v += dpp_f<0x141>(v); v += dpp_f<0x140>(v); return v; }
__device__ __forceinline__ float lane_bcast(float v, int l) { return __builtin_bit_cast(float, __builtin_amdgcn_readlane(__builtin_bit_cast(int, v), l)); }
__device__ __forceinline__ float wave_sum(float v) {
    v = sum16(v);
    return (lane_bcast(v, 0) + lane_bcast(v, 16)) + (lane_bcast(v, 32) + lane_bcast(v, 48));
}
__device__ __forceinline__ int tid_of(int wv) { int t = (wv << 6) | (int)__builtin_amdgcn_mbcnt_hi(~0u, __builtin_amdgcn_mbcnt_lo(~0u, 0u)); asm volatile("" : "+v"(t)); return t; }
__device__ __forceinline__ float siluf(float x) { return x * __builtin_amdgcn_rcpf(1.0f + __expf(-x)); }

#define XB_TMO      128
#define XB_XCNT(j)  (256  + 64 * (j))
#define XB_XSUB(j)  (1280 + 64 * (j))
#define XB_XGEN(j)  (2304 + 64 * (j))
#define XB_TOP      3328
#define XB_TOPGEN   3392
#define XCD_BAR_WORDS 3456
#define XB_SPIN_CAP (1u << 20)
__device__ __forceinline__ unsigned xb_ld(unsigned* p)              { return __hip_atomic_load(p, __ATOMIC_RELAXED, __HIP_MEMORY_SCOPE_AGENT); }
__device__ __forceinline__ unsigned xb_add(unsigned* p, unsigned v) { return __hip_atomic_fetch_add(p, v, __ATOMIC_RELAXED, __HIP_MEMORY_SCOPE_AGENT); }
__device__ __forceinline__ unsigned xb_xcc_id() { return (unsigned)__builtin_amdgcn_s_getreg((3 << 11) | 20) & 0xFu; }
#define XB_SPIN(cond, bar) do { unsigned _sp = 0; while (cond) { __builtin_amdgcn_s_sleep(1); \
    if ((++_sp & 255u) == 0u) { if (xb_ld(&(bar)[XB_TMO])) break; if (_sp > XB_SPIN_CAP) { atomicAdd(&(bar)[XB_TMO], 1u); break; } } } } while (0)
struct XcdBarrier { unsigned* bar; unsigned x; volatile LAS unsigned* st; };
__device__ __forceinline__ XcdBarrier xcd_barrier_post(unsigned* bar, volatile LAS unsigned* st) {
    XcdBarrier b; b.bar = bar; b.x = xb_xcc_id(); b.st = st;
    if (threadIdx.x == 0) (void)xb_add(&bar[XB_XCNT(b.x)], 1u);
    return b;
}
__device__ __forceinline__ void xcd_barrier_complete(unsigned* bar, unsigned x, unsigned& nloc, unsigned& nx) {
    const unsigned G = gridDim.x * gridDim.y * gridDim.z;
    unsigned sum, cnt, mine, sp = 0u;
    for (;;) {
        sum = 0u; cnt = 0u; mine = 0u;
#pragma unroll
        for (unsigned j = 0; j < 16; ++j) { const unsigned c = xb_ld(&bar[XB_XCNT(j)]); sum += c; cnt += (c > 0u) ? 1u : 0u; mine = (j == x) ? c : mine; }
        if (sum == G) break;
        __builtin_amdgcn_s_sleep(1);
        if ((++sp & 255u) == 0u) { if (xb_ld(&bar[XB_TMO])) break; if (sp > XB_SPIN_CAP) { atomicAdd(&bar[XB_TMO], 1u); break; } }
    }
    nloc = mine > 0u ? mine : 1u; nx = cnt > 0u ? cnt : 1u;
}
__device__ __forceinline__ void xcd_barrier(const XcdBarrier& b) {
    asm volatile("s_waitcnt vmcnt(0)" ::: "memory");
    __syncthreads();
    if (threadIdx.x == 0) {
        unsigned* bar = b.bar;
        __builtin_amdgcn_s_waitcnt(0);
        unsigned nloc = b.st[0], nx = b.st[1];
        if (nloc == 0u) { xcd_barrier_complete(bar, b.x, nloc, nx); b.st[0] = nloc; b.st[1] = nx; }
        const unsigned old = xb_add(&bar[XB_XSUB(b.x)], 1u);
        const unsigned gen = old / nloc;
        if (old + 1u == (gen + 1u) * nloc) {
            __builtin_amdgcn_fence(__ATOMIC_RELEASE, "agent");
            asm volatile("s_waitcnt vmcnt(0)" ::: "memory");
            const unsigned og = xb_add(&bar[XB_TOP], 1u);
            const unsigned tg = og / nx;
            if (og + 1u == (tg + 1u) * nx) xb_add(&bar[XB_TOPGEN], 1u);
            else XB_SPIN(xb_ld(&bar[XB_TOPGEN]) == tg, bar);
            __builtin_amdgcn_fence(__ATOMIC_ACQUIRE, "agent");
            xb_add(&bar[XB_XGEN(b.x)], 1u);
            asm volatile("s_waitcnt vmcnt(0)" ::: "memory");
        } else {
            XB_SPIN(xb_ld(&bar[XB_XGEN(b.x)]) == gen, bar);
            __builtin_amdgcn_fence(__ATOMIC_ACQUIRE, "agent");
            asm volatile("s_waitcnt vmcnt(0)" ::: "memory");
        }
    }
    __syncthreads();
}

namespace pg8 {
constexpr int BM = 256, BK = 64, HALF = 128, HTB = HALF * BK * 2, STAGE_BYTES = 8 * HTB, NXCD = 8, WGM = 8;
__host__ __device__ __forceinline__ int lds_byte(int r, int c) { const int st = (r >> 4) * 2 + (c >> 5), rr = r & 15, cc = c & 31, ob = rr * 64 + cc * 2; return st * 1024 + (ob ^ (((ob >> 9) & 1) << 5)); }
__host__ __device__ __forceinline__ void stage_rc(int b, int& R, int& C) { const int st = b / 1024, sb = b % 1024, swz = sb ^ (((sb >> 9) & 1) << 5); R = (st >> 1) * 16 + swz / 64; C = (st & 1) * 32 + (swz % 64) / 2; }
__host__ __device__ __forceinline__ int perm32(int rho) { const int n = rho >> 4, i = rho & 15; return 8 * (i >> 2) + 4 * n + (i & 3); }
struct Unit { int pm, pn; };
struct Gemm { const bf16_t* A; const bf16_t* Bt; int M, N, K, lda, ldb; };
struct StaticOrder {
    int nM, nN, nwg, G, c;
    __device__ void init(int M, int N, int G_, int c_) { nM = M / BM; nN = N / BM; nwg = nM * nN; G = G_; c = c_; }
    __device__ bool next(int i, Unit& u) const {
        const long L = (long)i * G + c; if (L >= nwg) return false;
        int wgid = (int)L; { const int q = nwg / NXCD, r = nwg % NXCD, xcd = wgid % NXCD, off = wgid / NXCD; wgid = (xcd < r ? xcd * (q + 1) : r * (q + 1) + (xcd - r) * q) + off; }
        const int nig = WGM * nN, gid = wgid / nig, fm = gid * WGM, gsz = (nM - fm) < WGM ? (nM - fm) : WGM;
        u.pm = fm + ((wgid % nig) % gsz); u.pn = (wgid % nig) / gsz; return true;
    }
};
struct TailOrder {
    int c;
    __device__ bool next(int i, Unit& u) const { if (i > 0 || c >= 256) return false; const int tix = c >> 2; u.pm = 64 + (tix >> 3); u.pn = tix & 7; return true; }
};
template <class Epi, class Order>
__device__ __forceinline__ void gemm_phase(LAS unsigned char* lds, const Gemm g, const Order& S, const Epi& E, int wv) {
    const int tid = tid_of(wv), wid = wv, lane = tid & 63, wr = wid >> 2, wc = wid & 3, fr = lane & 15, fq = lane >> 4;
    const int K = g.K, nt = K / BK;
    unsigned voffA[2], voffB[2];
#pragma unroll
    for (int i = 0; i < 2; ++i) { int R, C; stage_rc(tid * 16 + i * 8192, R, C); const int Rb = Epi::PERM ? ((R & ~31) + perm32(R & 31)) : R;
        voffA[i] = (unsigned)(R * g.lda + C) * 2u; voffB[i] = (unsigned)(Rb * g.ldb + C) * 2u; }
    const size_t kstep = (size_t)(BK * 2);
    const size_t hstepA = (size_t)HALF * g.lda * 2, hstepB = (size_t)HALF * g.ldb * 2;
    const size_t tstepA = 2 * hstepA, tstepB = 2 * hstepB;
    const unsigned ldsw = (unsigned)wid * 1024u;
    const int aoff = lds_byte(wr * 64 + fr, fq * 8), boff = lds_byte(wc * 32 + fr, fq * 8);
#define PG8_SA(b, h) (((b) * 2 + (h)) * HTB)
#define PG8_SB(b, h) ((4 + (b) * 2 + (h)) * HTB)
#define PG8_STAGE(bufoff, gbase, voff) do { _Pragma("unroll") for (int _i = 0; _i < 2; ++_i) \
        __builtin_amdgcn_global_load_lds((const unsigned*)((const char*)(gbase) + (voff)[_i]), (LAS unsigned*)(lds + (bufoff) + ldsw + _i * 8192), 16, 0, 0); } while (0)
#define PG8_LDA(dst, b, h) do { _Pragma("unroll") for (int m = 0; m < 4; ++m) _Pragma("unroll") for (int k = 0; k < 2; ++k) dst[m][k] = *(const LAS bf16x8*)(lds + PG8_SA(b, h) + aoff + m * 2048 + k * 1024); } while (0)
#define PG8_LDB(dst, b, h) do { _Pragma("unroll") for (int n = 0; n < 2; ++n) _Pragma("unroll") for (int k = 0; k < 2; ++k) dst[n][k] = *(const LAS bf16x8*)(lds + PG8_SB(b, h) + boff + n * 2048 + k * 1024); } while (0)
#define PG8_MMA(ai, bj, At, Bt) do { __builtin_amdgcn_s_setprio(1); _Pragma("unroll") for (int m = 0; m < 4; ++m) _Pragma("unroll") for (int n = 0; n < 2; ++n) _Pragma("unroll") for (int k = 0; k < 2; ++k) \
        acc[ai][bj][m][n] = __builtin_amdgcn_mfma_f32_16x16x32_bf16(Bt[n][k], At[m][k], acc[ai][bj][m][n], 0, 0, 0); __builtin_amdgcn_s_setprio(0); } while (0)
#define PG8_WAIT_V(n) asm volatile("s_waitcnt vmcnt(" #n ")" ::: "memory")
#define PG8_WAIT_L(n) asm volatile("s_waitcnt lgkmcnt(" #n ")" ::: "memory")
#define PG8_BAR __builtin_amdgcn_s_barrier()
#define PG8_SCHED __builtin_amdgcn_sched_barrier(0)
    Unit cur, nxt; int ui = 0;
    if (!S.next(0, cur)) return;
    f32x4 acc[2][2][4][2];
#pragma unroll
    for (int a = 0; a < 2; ++a)
#pragma unroll
        for (int b = 0; b < 2; ++b)
#pragma unroll
            for (int m = 0; m < 4; ++m)
#pragma unroll
                for (int n = 0; n < 2; ++n) acc[a][b][m][n] = (f32x4){0.f, 0.f, 0.f, 0.f};
    bf16x8 At[4][2], B0[2][2], B1[2][2];
    const char* cA = (const char*)g.A + (size_t)cur.pm * tstepA; const char* cB = (const char*)g.Bt + (size_t)cur.pn * tstepB;
    int wbuf = 0;
    if constexpr (Epi::LDSW) E.stage_w(cur, 0, wv);
    PG8_STAGE(PG8_SB(0, 0), cB, voffB); PG8_STAGE(PG8_SB(0, 1), cB + hstepB, voffB); PG8_STAGE(PG8_SA(0, 0), cA, voffA); PG8_STAGE(PG8_SA(0, 1), cA + hstepA, voffA);
    if (wr == 1) PG8_BAR;
    PG8_WAIT_V(2); PG8_BAR;
    PG8_STAGE(PG8_SB(1, 0), cB + kstep, voffB); PG8_STAGE(PG8_SA(1, 0), cA + kstep, voffA); PG8_STAGE(PG8_SB(1, 1), cB + hstepB + kstep, voffB);
    PG8_WAIT_V(6); PG8_BAR;
#define PG8_WAIT_VN(n) asm volatile("s_waitcnt vmcnt(%0)" :: "n"(n) : "memory")
#define PG8_TRIP(ST11, W1, W2, W3, W4) do { \
            const bool last = (t == nt - 2); \
            const char* a1 = cA + (size_t)(t + 1) * kstep; \
            const char* a2 = last ? nA : cA + (size_t)(t + 2) * kstep; const char* b2 = last ? nB : cB + (size_t)(t + 2) * kstep; \
            const char* a3 = a2 + kstep; const char* b3 = b2 + kstep; \
            PG8_LDB(B0, 0, 0); PG8_LDB(B1, 0, 1); PG8_SCHED; PG8_LDA(At, 0, 0); if (ST11) PG8_STAGE(PG8_SA(1, 1), a1 + hstepA, voffA); \
            PG8_WAIT_VN(W1); PG8_WAIT_L(0); PG8_BAR; PG8_MMA(0, 0, At, B0); PG8_MMA(0, 1, At, B1); PG8_BAR; PG8_SCHED; \
            PG8_LDA(At, 0, 1); PG8_STAGE(PG8_SB(0, 0), b2, voffB); PG8_STAGE(PG8_SB(0, 1), b2 + hstepB, voffB); PG8_STAGE(PG8_SA(0, 0), a2, voffA); \
            PG8_WAIT_VN(W2); PG8_WAIT_L(0); PG8_BAR; PG8_MMA(1, 0, At, B0); PG8_MMA(1, 1, At, B1); PG8_BAR; PG8_SCHED; \
            PG8_LDB(B0, 1, 0); PG8_LDB(B1, 1, 1); PG8_SCHED; PG8_LDA(At, 1, 0); PG8_STAGE(PG8_SA(0, 1), a2 + hstepA, voffA); \
            PG8_WAIT_VN(W3); PG8_WAIT_L(0); PG8_BAR; PG8_MMA(0, 0, At, B0); PG8_MMA(0, 1, At, B1); PG8_BAR; PG8_SCHED; \
            PG8_LDA(At, 1, 1); PG8_STAGE(PG8_SB(1, 0), b3, voffB); PG8_STAGE(PG8_SB(1, 1), b3 + hstepB, voffB); PG8_STAGE(PG8_SA(1, 0), a3, voffA); \
            PG8_WAIT_VN(W4); PG8_WAIT_L(0); PG8_BAR; PG8_MMA(1, 0, At, B0); PG8_MMA(1, 1, At, B1); PG8_BAR; PG8_SCHED; } while (0)
    constexpr int EV = Epi::VMOPS > 40 ? 40 : Epi::VMOPS;
    bool pre = false;
    for (;;) {
        const bool has_next = S.next(ui + 1, nxt);
        const char* nA = has_next ? (const char*)g.A + (size_t)nxt.pm * tstepA : cA; const char* nB = has_next ? (const char*)g.Bt + (size_t)nxt.pn * tstepB : cB;
        int t = 0;
        if (pre) { PG8_TRIP(false, 8 + EV, 8 + EV, 8 + EV, 8); t = 2; }
        for (; t < nt; t += 2) PG8_TRIP(true, 8, 8, 8, 8);
        if (Epi::PRESTAGE && has_next) { PG8_STAGE(PG8_SA(1, 1), nA + kstep + hstepA, voffA); pre = true; }
        if constexpr (Epi::LDSW) { if (has_next) E.stage_w(nxt, wbuf ^ 1, wv); }
        if (wr == 0) PG8_BAR;
        PG8_SCHED;
        { const int l2 = tid_of(wv) & 63; if constexpr (Epi::LDSW) E.run(acc, cur, wr, wc, l2 & 15, l2 >> 4, wbuf); else E(acc, cur, wr, wc, l2 & 15, l2 >> 4); }
        PG8_SCHED;
        if (!has_next) break;
#pragma unroll
        for (int a = 0; a < 2; ++a)
#pragma unroll
            for (int b = 0; b < 2; ++b)
#pragma unroll
                for (int m = 0; m < 4; ++m)
#pragma unroll
                    for (int n = 0; n < 2; ++n) { acc[a][b][m][n] = (f32x4){0.f, 0.f, 0.f, 0.f}; asm volatile("" : "+v"(acc[a][b][m][n])); }
        cur = nxt; cA = nA; cB = nB; ++ui; wbuf ^= 1;
        if (wr == 1) PG8_BAR;
    }
#undef PG8_TRIP
#undef PG8_WAIT_VN
    PG8_WAIT_V(0);
    PG8_BAR;
#undef PG8_SA
#undef PG8_SB
#undef PG8_STAGE
#undef PG8_LDA
#undef PG8_LDB
#undef PG8_MMA
#undef PG8_WAIT_V
#undef PG8_WAIT_L
#undef PG8_BAR
#undef PG8_SCHED
}

__device__ __forceinline__ int mod_row_of_tile(int pm) { return pm < 64 ? (pm >> 3) : 8; }

struct EpiResid {
    static constexpr bool LDSW = false; static constexpr bool PRESTAGE = true; static constexpr bool PERM = true; static constexpr int VMOPS = 16;
    bf16_t* X; const float* gate;
    __device__ __forceinline__ void operator()(const f32x4 (&acc)[2][2][4][2], const Unit& u, int wr, int wc, int fr, int fq) const {
        const int row0 = u.pm * BM + wr * 64 + fr, col0 = u.pn * BM + wc * 32 + 8 * fq;
        const float* gp = gate + (size_t)mod_row_of_tile(u.pm) * MODW + col0;
        f32x4 gv[2][2];
#pragma unroll
        for (int bj = 0; bj < 2; ++bj)
#pragma unroll
            for (int n = 0; n < 2; ++n) gv[bj][n] = *(const f32x4*)(gp + bj * HALF + 4 * n);
#pragma unroll
        for (int ai = 0; ai < 2; ++ai) {
            u32x4 xb[4][2];
#pragma unroll
            for (int m = 0; m < 4; ++m) { const bf16_t* srcp = X + (size_t)(row0 + ai * HALF + m * 16) * DM + col0;
#pragma unroll
                for (int bj = 0; bj < 2; ++bj) xb[m][bj] = *(const u32x4*)(srcp + bj * HALF); }
            asm volatile("" ::: "memory");
#pragma unroll
            for (int m = 0; m < 4; ++m) { bf16_t* rowp = X + (size_t)(row0 + ai * HALF + m * 16) * DM + col0;
#pragma unroll
                for (int bj = 0; bj < 2; ++bj) { const u32x4 q = xb[m][bj]; const f32x4 a0 = acc[ai][bj][m][0], a1 = acc[ai][bj][m][1], g0 = gv[bj][0], g1 = gv[bj][1];
                    u32x4 w;
                    w.x = pk_xs(xs_lo(q.x) + g0[0] * a0[0], xs_hi(q.x) + g0[1] * a0[1]); w.y = pk_xs(xs_lo(q.y) + g0[2] * a0[2], xs_hi(q.y) + g0[3] * a0[3]);
                    w.z = pk_xs(xs_lo(q.z) + g1[0] * a1[0], xs_hi(q.z) + g1[1] * a1[1]); w.w = pk_xs(xs_lo(q.w) + g1[2] * a1[2], xs_hi(q.w) + g1[3] * a1[3]);
                    *(u32x4*)(rowp + bj * HALF) = w; } }
            asm volatile("" ::: "memory");
        }
    }
};
struct EpiPartial {
    static constexpr bool LDSW = false; static constexpr bool PRESTAGE = true; static constexpr bool PERM = false; static constexpr int VMOPS = 32;
    float* P;
    __device__ __forceinline__ void operator()(const f32x4 (&acc)[2][2][4][2], const Unit& u, int wr, int wc, int fr, int fq) const {
        const int row0 = wr * 64 + fr, col0 = wc * 32 + 4 * fq;
#pragma unroll
        for (int ai = 0; ai < 2; ++ai)
#pragma unroll
            for (int m = 0; m < 4; ++m) { float* rowp = P + (size_t)(row0 + ai * HALF + m * 16) * 256 + col0;
#pragma unroll
                for (int bj = 0; bj < 2; ++bj)
#pragma unroll
                    for (int n = 0; n < 2; ++n) *(f32x4*)(rowp + bj * HALF + n * 16) = acc[ai][bj][m][n]; }
    }
};
struct EpiBf16 {
    static constexpr bool LDSW = false; static constexpr bool PRESTAGE = true; static constexpr bool PERM = true; static constexpr int VMOPS = 16;
    bf16_t* O; int ldc;
    __device__ __forceinline__ void operator()(const f32x4 (&acc)[2][2][4][2], const Unit& u, int wr, int wc, int fr, int fq) const {
        const int row0 = u.pm * BM + wr * 64 + fr, col0 = u.pn * BM + wc * 32 + 8 * fq;
#pragma unroll
        for (int ai = 0; ai < 2; ++ai)
#pragma unroll
            for (int m = 0; m < 4; ++m) { bf16_t* rowp = O + (size_t)(row0 + ai * HALF + m * 16) * ldc + col0;
#pragma unroll
                for (int bj = 0; bj < 2; ++bj) { const f32x4 v0 = acc[ai][bj][m][0], v1 = acc[ai][bj][m][1];
                    u32x4 w; w.x = pk_bf16(v0[0], v0[1]); w.y = pk_bf16(v0[2], v0[3]); w.z = pk_bf16(v1[0], v1[1]); w.w = pk_bf16(v1[2], v1[3]);
                    *(u32x4*)(rowp + bj * HALF) = w; } }
    }
};
struct EpiQKV {
    static constexpr bool LDSW = false; static constexpr bool PRESTAGE = true; static constexpr bool PERM = true; static constexpr int VMOPS = 16;
    bf16_t* O; const float* rope;
    __device__ __forceinline__ void operator()(const f32x4 (&acc)[2][2][4][2], const Unit& u, int wr, int wc, int fr, int fq) const {
        const int row0 = u.pm * BM + wr * 64 + fr, col0 = u.pn * BM + wc * 32 + 8 * fq;
        const bool rot = (u.pn < 16) && (u.pm < 64);
        const int axis = wc >> 1, f0 = (wc & 1) * 16 + 4 * fq;
        f32x4 csa[2][4], csb[2][4];
#pragma unroll
        for (int ai = 0; ai < 2; ++ai)
#pragma unroll
            for (int m = 0; m < 4; ++m) { csa[ai][m] = (f32x4){1.f, 0.f, 1.f, 0.f}; csb[ai][m] = (f32x4){1.f, 0.f, 1.f, 0.f};
                if (rot) { const int t = (row0 + ai * HALF + m * 16) & (SEQ - 1); const int pos = axis ? (t & 63) : (t >> 6); const float* rp = rope + ((size_t)pos * 32 + f0) * 2;
                    csa[ai][m] = *(const f32x4*)rp; csb[ai][m] = *(const f32x4*)(rp + 4); } }
        asm volatile("" ::: "memory");
#pragma unroll
        for (int ai = 0; ai < 2; ++ai)
#pragma unroll
            for (int m = 0; m < 4; ++m) { const int row = row0 + ai * HALF + m * 16; bf16_t* rowp = O + (size_t)row * DA_QKVW + col0;
                const f32x4 cs0 = csa[ai][m], cs1 = csb[ai][m];
#pragma unroll
                for (int bj = 0; bj < 2; ++bj) { const f32x4 v0 = acc[ai][bj][m][0], v1 = acc[ai][bj][m][1];
                    f32x4 o0, o1;
                    o0[0] = v0[0] * cs0[0] - v0[1] * cs0[1]; o0[1] = v0[1] * cs0[0] + v0[0] * cs0[1];
                    o0[2] = v0[2] * cs0[2] - v0[3] * cs0[3]; o0[3] = v0[3] * cs0[2] + v0[2] * cs0[3];
                    o1[0] = v1[0] * cs1[0] - v1[1] * cs1[1]; o1[1] = v1[1] * cs1[0] + v1[0] * cs1[1];
                    o1[2] = v1[2] * cs1[2] - v1[3] * cs1[3]; o1[3] = v1[3] * cs1[2] + v1[2] * cs1[3];
                    u32x4 w; w.x = pk_bf16(o0[0], o0[1]); w.y = pk_bf16(o0[2], o0[3]); w.z = pk_bf16(o1[0], o1[1]); w.w = pk_bf16(o1[2], o1[3]);
                    *(u32x4*)(rowp + bj * HALF) = w; } }
    }
};
struct EpiUpAct {
    static constexpr bool LDSW = true; static constexpr bool PRESTAGE = true; static constexpr bool PERM = true; static constexpr int VMOPS = 18;
    bf16_t* ACT; bf16_t* EDGE; const float* cw; LAS unsigned char* wl;
    __device__ __forceinline__ void stage_w(const Unit& u, int buf, int wv) const {
        const int ln = tid_of(wv) & 63;
#pragma unroll
        for (int q = 0; q < 2; ++q) { const int i0 = q ? 512 + (wv & 3) * 64 : wv * 64, k = i0 >> 8, h = (i0 >> 7) & 1, chb = i0 & 127;
            __builtin_amdgcn_global_load_lds((const unsigned*)(cw + (size_t)k * DFF2 + h * DFF + u.pn * 128 + chb + ln), (LAS unsigned*)(wl + buf * 3072 + i0 * 4), 4, 0, 0); }
    }
    __device__ __forceinline__ void run(const f32x4 (&acc)[2][2][4][2], const Unit& u, int wr, int wc, int fr, int fq, int buf) const {
        const int c8 = wc * 32 + 8 * fq; int c0 = u.pn * 128 + c8;
        asm volatile("" : "+v"(c0) :: "memory");
        const bool first = fr == 0, lastr = fr == 15;
        unsigned st[2][4][2];
#pragma unroll
        for (int n = 0; n < 2; ++n) {
            f32x4 wgt[3][2];
#pragma unroll
            for (int k = 0; k < 3; ++k)
#pragma unroll
                for (int h = 0; h < 2; ++h) wgt[k][h] = *(const LAS f32x4*)(wl + buf * 3072 + ((k * 2 + h) * 128 + c8 + 4 * n) * 4);
#pragma unroll
            for (int ai = 0; ai < 2; ++ai) {
                const int rowb = u.pm * BM + ai * HALF + wr * 64;
#pragma unroll
                for (int m = 0; m < 4; ++m) {
                    f32x4 y[2];
#pragma unroll
                    for (int h = 0; h < 2; ++h)
#pragma unroll
                        for (int e = 0; e < 4; ++e) {
                            const float cur = acc[ai][h][m][n][e];
                            const float pin = dpp_f<0x121>(cur), nin = dpp_f<0x12F>(cur);
                            const float pout = m > 0 ? dpp_f<0x121>(acc[ai][h][m > 0 ? m - 1 : 0][n][e]) : 0.f;
                            const float nout = m < 3 ? dpp_f<0x12F>(acc[ai][h][m < 3 ? m + 1 : 3][n][e]) : 0.f;
                            const float pv = first ? pout : pin, nv = lastr ? nout : nin;
                            y[h][e] = wgt[0][h][e] * pv + wgt[1][h][e] * cur + wgt[2][h][e] * nv;
                        }
                    const float o0 = siluf(y[0][0]) * y[1][0], o1 = siluf(y[0][1]) * y[1][1], o2 = siluf(y[0][2]) * y[1][2], o3 = siluf(y[0][3]) * y[1][3];
                    if (n == 0) { st[ai][m][0] = pk_bf16(o0, o1); st[ai][m][1] = pk_bf16(o2, o3); }
                    else { u32x4 pkd; pkd.x = st[ai][m][0]; pkd.y = st[ai][m][1]; pkd.z = pk_bf16(o0, o1); pkd.w = pk_bf16(o2, o3);
                        *(u32x4*)(ACT + (size_t)(rowb + m * 16 + fr) * DFF + c0) = pkd; }
                }
            }
        }
#pragma unroll
        for (int ai = 0; ai < 2; ++ai) {
            const int rowb = u.pm * BM + ai * HALF + wr * 64;
            bf16_t* eb = EDGE + ((size_t)(rowb >> 6) * 4) * DFF2 + (size_t)u.pn * 256 + c8;
#pragma unroll
            for (int mm = 0; mm < 2; ++mm) { const int m = mm ? 3 : 0; const int er = mm ? fr - 12 : fr;
                if (mm ? fr >= 14 : fr < 2) {
                    const f32x4 g0 = acc[ai][0][m][0], g1 = acc[ai][0][m][1], v0 = acc[ai][1][m][0], v1 = acc[ai][1][m][1];
                    u32x4 a, b; a.x = pk_bf16(g0[0], g0[1]); a.y = pk_bf16(g0[2], g0[3]); a.z = pk_bf16(g1[0], g1[1]); a.w = pk_bf16(g1[2], g1[3]);
                    b.x = pk_bf16(v0[0], v0[1]); b.y = pk_bf16(v0[2], v0[3]); b.z = pk_bf16(v1[0], v1[1]); b.w = pk_bf16(v1[2], v1[3]);
                    *(u32x4*)(eb + (size_t)er * DFF2) = a; *(u32x4*)(eb + (size_t)er * DFF2 + 128) = b; } }
        }
    }
};
struct EpiGdnIn {
    static constexpr bool LDSW = false; static constexpr bool PRESTAGE = true; static constexpr bool PERM = true; static constexpr int VMOPS = 16;
    unsigned char* ws; bf16_t* Z; float* AB; bf16_t* EDGE; const float* cw;
    __device__ __forceinline__ void operator()(const f32x4 (&acc)[2][2][4][2], const Unit& u_, int wr, int wc, int fr, int fq) const {
        Unit u; u.pm = __builtin_amdgcn_readfirstlane(u_.pm); u.pn = __builtin_amdgcn_readfirstlane(u_.pn);
        const int row0 = u.pm * BM + wr * 64 + fr, cin = wc * 32 + 8 * fq;
        if (u.pn < 32) {
#pragma unroll
            for (int ai = 0; ai < 2; ++ai) {
                const int rowb = u.pm * BM + ai * HALF + wr * 64;
                bf16_t* eb = EDGE + ((size_t)(rowb >> 6) * 8) * GDN_QKVW + (size_t)u.pn * 256 + cin;
#pragma unroll
                for (int mm = 0; mm < 2; ++mm) { const int m = mm ? 3 : 0; const int er = mm ? fr - 8 : fr;
                    if (mm ? fr >= 12 : fr < 4) {
#pragma unroll
                        for (int bj = 0; bj < 2; ++bj) { const f32x4 v0 = acc[ai][bj][m][0], v1 = acc[ai][bj][m][1];
                            u32x4 w; w.x = pk_bf16(v0[0], v0[1]); w.y = pk_bf16(v0[2], v0[3]); w.z = pk_bf16(v1[0], v1[1]); w.w = pk_bf16(v1[2], v1[3]);
                            *(u32x4*)(eb + (size_t)er * GDN_QKVW + bj * HALF) = w; } } }
            }
            int c0 = u.pn * 256 + cin;
            asm volatile("" : "+v"(c0) :: "memory");
            const bool f1 = fr < 1, f2 = fr < 2, l1 = fr > 14, l2 = fr > 13;
            size_t boff = WS_VN; if (u.pn < 16) boff = WS_KN; if (u.pn < 8) boff = WS_QN;
            bf16_t* base = (bf16_t*)(ws + boff); const int ldc = u.pn < 16 ? 2048 : GDN_VW; const int col0 = (u.pn < 8 ? u.pn : (u.pn < 16 ? u.pn - 8 : u.pn - 16)) * BM + cin;
#pragma unroll
            for (int bj = 0; bj < 2; ++bj) {
                unsigned st[2][4][2];
#pragma unroll
                for (int n = 0; n < 2; ++n) {
                    f32x4 wk[5];
                    const float* wp = cw + c0 + bj * HALF + 4 * n;
#pragma unroll
                    for (int k = 0; k < 5; ++k) wk[k] = *(const f32x4*)(wp + (size_t)k * GDN_QKVW);
#pragma unroll
                    for (int ai = 0; ai < 2; ++ai) {
                        unsigned pkd[4][2];
#pragma unroll
                        for (int ep = 0; ep < 2; ++ep) {
                            float o[4][2];
#pragma unroll
                            for (int eh = 0; eh < 2; ++eh) { const int e = 2 * ep + eh;
                                float d2[4], d1[4], u1[4], u2[4];
#pragma unroll
                                for (int m = 0; m < 4; ++m) { const float cur = acc[ai][bj][m][n][e]; d2[m] = dpp_f<0x122>(cur); d1[m] = dpp_f<0x121>(cur); u1[m] = dpp_f<0x12F>(cur); u2[m] = dpp_f<0x12E>(cur); }
#pragma unroll
                                for (int m = 0; m < 4; ++m) {
                                    const float p2 = f2 ? (m > 0 ? d2[m > 0 ? m - 1 : 0] : 0.f) : d2[m], p1 = f1 ? (m > 0 ? d1[m > 0 ? m - 1 : 0] : 0.f) : d1[m];
                                    const float n1 = l1 ? (m < 3 ? u1[m < 3 ? m + 1 : 3] : 0.f) : u1[m], n2 = l2 ? (m < 3 ? u2[m < 3 ? m + 1 : 3] : 0.f) : u2[m];
                                    const float y = (wk[0][e] * p2 + wk[1][e] * p1) + (wk[2][e] * acc[ai][bj][m][n][e] + wk[3][e] * n1) + wk[4][e] * n2;
                                    o[m][eh] = siluf(y);
                                }
                            }
#pragma unroll
                            for (int m = 0; m < 4; ++m) pkd[m][ep] = pk_bf16(o[m][0], o[m][1]);
                        }
                        if (n == 0) {
#pragma unroll
                            for (int m = 0; m < 4; ++m) { st[ai][m][0] = pkd[m][0]; st[ai][m][1] = pkd[m][1]; }
                        } else {
                            bf16_t* gp = base + (size_t)(row0 + ai * HALF) * ldc + col0 + bj * HALF;
#pragma unroll
                            for (int m = 0; m < 4; ++m) { u32x4 w; w.x = st[ai][m][0]; w.y = st[ai][m][1]; w.z = pkd[m][0]; w.w = pkd[m][1]; *(u32x4*)(gp + (size_t)(m * 16) * ldc) = w; }
                        }
                    }
                }
            }
        } else if (u.pn < 48) {
            bf16_t* base = Z; const int ldc = GDN_VW; const int col0 = (u.pn - 32) * BM + cin;
#pragma unroll
            for (int ai = 0; ai < 2; ++ai)
#pragma unroll
                for (int m = 0; m < 4; ++m) { bf16_t* rowp = base + (size_t)(row0 + ai * HALF + m * 16) * ldc + col0;
#pragma unroll
                    for (int bj = 0; bj < 2; ++bj) { const f32x4 v0 = acc[ai][bj][m][0], v1 = acc[ai][bj][m][1];
                        u32x4 w; w.x = pk_bf16(v0[0], v0[1]); w.y = pk_bf16(v0[2], v0[3]); w.z = pk_bf16(v1[0], v1[1]); w.w = pk_bf16(v1[2], v1[3]);
                        *(u32x4*)(rowp + bj * HALF) = w; } }
        } else {
#pragma unroll
            for (int ai = 0; ai < 2; ++ai)
#pragma unroll
                for (int m = 0; m < 4; ++m) { float* rowp = AB + (size_t)(row0 + ai * HALF + m * 16) * 128 + cin;
                    *(f32x4*)(rowp) = acc[ai][0][m][0]; *(f32x4*)(rowp + 4) = acc[ai][0][m][1]; }
        }
    }
};
}

namespace att {
constexpr int D = 128, NW = 8, QBLK = 32, KVBLK = 64;
constexpr float SCALE = 0.088388347648318440f;
constexpr float THR = 8.f;
constexpr int SHM_V = KVBLK * D * 2, SHM_K = KVBLK * D * 2, SHM_ATTN = 2 * SHM_V + 2 * SHM_K + NW * 64 * 4;
#define KSWZ(row, colB) ((row) * 256 + ((colB) ^ (((row) & 7) << 4)))
#define SBAR() __builtin_amdgcn_sched_barrier(0)
__device__ __forceinline__ int crow(int r, int hi) { return (r & 3) + 8 * (r >> 2) + 4 * hi; }
__device__ __forceinline__ unsigned cvtpk(float lo, float hi) { unsigned r; asm volatile("v_cvt_pk_bf16_f32 %0, %1, %2" : "=v"(r) : "v"(lo), "v"(hi)); return r; }
__device__ __forceinline__ void partialSM(f32x16& p0, f32x16& p1, float& m_reg, float& mn, float& alpha) {
  constexpr float C = SCALE * 1.4426950408889634f;
  float pmax = p0[0];
#pragma unroll
  for (int r = 1; r < 16; ++r) pmax = fmaxf(pmax, p0[r]);
#pragma unroll
  for (int r = 0; r < 16; ++r) pmax = fmaxf(pmax, p1[r]);
  { auto rr = __builtin_amdgcn_permlane32_swap(__float_as_uint(pmax), __float_as_uint(pmax), false, false);
    pmax = fmaxf(__uint_as_float(rr[0]), __uint_as_float(rr[1])); }
  if (__builtin_expect(__all(pmax - m_reg <= THR / SCALE), 1)) { mn = m_reg; alpha = 1.f; }
  else { mn = fmaxf(m_reg, pmax); alpha = __builtin_amdgcn_exp2f((m_reg - mn) * C); m_reg = mn; }
  float mnC = -mn * C;
#pragma unroll
  for (int r = 0; r < 16; ++r) p0[r] = fmaf(p0[r], C, mnC);
#pragma unroll
  for (int r = 0; r < 16; ++r) p1[r] = fmaf(p1[r], C, mnC);
#pragma unroll
  for (int r = 0; r < 16; ++r) p0[r] = __builtin_amdgcn_exp2f(p0[r]);
}
__device__ __forceinline__ void finishSM(f32x16& p0, f32x16& p1, float alpha, float& l_reg, bf16x8& pa0, bf16x8& pa1, bf16x8& pa2, bf16x8& pa3) {
#pragma unroll
  for (int r = 0; r < 16; ++r) p1[r] = __builtin_amdgcn_exp2f(p1[r]);
  float ps = 0;
#pragma unroll
  for (int r = 0; r < 16; ++r) ps += p0[r];
#pragma unroll
  for (int r = 0; r < 16; ++r) ps += p1[r];
  { auto rr = __builtin_amdgcn_permlane32_swap(__float_as_uint(ps), __float_as_uint(ps), false, false);
    ps = __uint_as_float(rr[0]) + __uint_as_float(rr[1]); }
  l_reg = l_reg * alpha + ps;
#define PK4(P, BASE, OUT) do { unsigned a0 = cvtpk(P[BASE + 0], P[BASE + 1]), a1 = cvtpk(P[BASE + 2], P[BASE + 3]);   \
    unsigned b0 = cvtpk(P[BASE + 4], P[BASE + 5]), b1 = cvtpk(P[BASE + 6], P[BASE + 7]);                              \
    auto r0 = __builtin_amdgcn_permlane32_swap(a0, b0, false, false); auto r1 = __builtin_amdgcn_permlane32_swap(a1, b1, false, false); \
    u32x4 w = {r0[0], r1[0], r0[1], r1[1]}; OUT = __builtin_bit_cast(bf16x8, w); } while (0)
  PK4(p0, 0, pa0); PK4(p0, 8, pa1); PK4(p1, 0, pa2); PK4(p1, 8, pa3);
#undef PK4
}
__device__ __forceinline__ void qkt(f32x16& p0, f32x16& p1, const char* Ks, const bf16x8* qr, int r32, int hi) {
#pragma unroll
  for (int r = 0; r < 16; ++r) { p0[r] = 0.f; p1[r] = 0.f; }
#pragma unroll
  for (int d0 = 0; d0 < 8; ++d0) { int cb = (d0 * 16 + hi * 8) * 2;
    bf16x8 b0 = *reinterpret_cast<const bf16x8*>(Ks + KSWZ(r32, cb));
    bf16x8 b1 = *reinterpret_cast<const bf16x8*>(Ks + KSWZ(32 + r32, cb));
    p0 = __builtin_amdgcn_mfma_f32_32x32x16_bf16(b0, qr[d0], p0, 0, 0, 0);
    p1 = __builtin_amdgcn_mfma_f32_32x32x16_bf16(b1, qr[d0], p1, 0, 0, 0); }
}
__device__ __forceinline__ int v_st(int k, int c) { const int kk = (k & ~0xC) | ((k & 4) << 1) | ((k & 8) >> 1); return ((kk >> 3) * 4 + (c >> 5)) * 512 + ((kk & 7) * 32 + (c & 31)) * 2; }
__device__ __forceinline__ int v_rd_base(int lane) { return ((lane & 3) << 3) | (((lane >> 2) & 3) << 6) | (((lane >> 4) & 1) << 5) | (((lane >> 5) & 1) << 8); }
constexpr int v_rd_off(int d0, int ks, int half) { return d0 * 512 + ks * 4096 + half * 2048; }
template <int OFF> __device__ __forceinline__ s16x4 tr_read(int vb) {
  s16x4 r; asm volatile("ds_read_b64_tr_b16 %0, %1 offset:%2" : "=&v"(r) : "v"(vb), "i"(OFF) : "memory"); return r;
}
template <int D0> __device__ __forceinline__ void pv_one(f32x16& od, int vb, bf16x8 pa0, bf16x8 pa1, bf16x8 pa2, bf16x8 pa3) {
  const s16x4 l0 = tr_read<v_rd_off(D0, 0, 0)>(vb), h0 = tr_read<v_rd_off(D0, 0, 1)>(vb), l1 = tr_read<v_rd_off(D0, 1, 0)>(vb), h1 = tr_read<v_rd_off(D0, 1, 1)>(vb);
  const s16x4 l2 = tr_read<v_rd_off(D0, 2, 0)>(vb), h2 = tr_read<v_rd_off(D0, 2, 1)>(vb), l3 = tr_read<v_rd_off(D0, 3, 0)>(vb), h3 = tr_read<v_rd_off(D0, 3, 1)>(vb);
  asm volatile("s_waitcnt lgkmcnt(0)" ::: "memory"); SBAR();
#define PK(L, H) (bf16x8){L[0], L[1], L[2], L[3], H[0], H[1], H[2], H[3]}
  od = __builtin_amdgcn_mfma_f32_32x32x16_bf16(pa0, PK(l0, h0), od, 0, 0, 0);
  od = __builtin_amdgcn_mfma_f32_32x32x16_bf16(pa1, PK(l1, h1), od, 0, 0, 0);
  od = __builtin_amdgcn_mfma_f32_32x32x16_bf16(pa2, PK(l2, h2), od, 0, 0, 0);
  od = __builtin_amdgcn_mfma_f32_32x32x16_bf16(pa3, PK(l3, h3), od, 0, 0, 0);
#undef PK
}
template <int D0> __device__ __forceinline__ void pv_one_lite(f32x16& od, int vb, bf16x8 pa0, bf16x8 pa1, bf16x8 pa2, bf16x8 pa3) {
#define PK(L, H) (bf16x8){L[0], L[1], L[2], L[3], H[0], H[1], H[2], H[3]}
  { const s16x4 l0 = tr_read<v_rd_off(D0, 0, 0)>(vb), h0 = tr_read<v_rd_off(D0, 0, 1)>(vb), l1 = tr_read<v_rd_off(D0, 1, 0)>(vb), h1 = tr_read<v_rd_off(D0, 1, 1)>(vb);
    asm volatile("s_waitcnt lgkmcnt(0)" ::: "memory"); SBAR();
    od = __builtin_amdgcn_mfma_f32_32x32x16_bf16(pa0, PK(l0, h0), od, 0, 0, 0); od = __builtin_amdgcn_mfma_f32_32x32x16_bf16(pa1, PK(l1, h1), od, 0, 0, 0); }
  { const s16x4 l2 = tr_read<v_rd_off(D0, 2, 0)>(vb), h2 = tr_read<v_rd_off(D0, 2, 1)>(vb), l3 = tr_read<v_rd_off(D0, 3, 0)>(vb), h3 = tr_read<v_rd_off(D0, 3, 1)>(vb);
    asm volatile("s_waitcnt lgkmcnt(0)" ::: "memory"); SBAR();
    od = __builtin_amdgcn_mfma_f32_32x32x16_bf16(pa2, PK(l2, h2), od, 0, 0, 0); od = __builtin_amdgcn_mfma_f32_32x32x16_bf16(pa3, PK(l3, h3), od, 0, 0, 0); }
#undef PK
}
__device__ __forceinline__ void pv_d0_lite(f32x16& o0, f32x16& o1, f32x16& o2, f32x16& o3, int vb, bf16x8 pa0, bf16x8 pa1, bf16x8 pa2, bf16x8 pa3) {
  pv_one_lite<0>(o0, vb, pa0, pa1, pa2, pa3); pv_one_lite<1>(o1, vb, pa0, pa1, pa2, pa3); pv_one_lite<2>(o2, vb, pa0, pa1, pa2, pa3); pv_one_lite<3>(o3, vb, pa0, pa1, pa2, pa3);
}
__device__ __forceinline__ void pv_d0(f32x16& o0, f32x16& o1, f32x16& o2, f32x16& o3, int vb, bf16x8 pa0, bf16x8 pa1, bf16x8 pa2, bf16x8 pa3) {
  pv_one<0>(o0, vb, pa0, pa1, pa2, pa3); pv_one<1>(o1, vb, pa0, pa1, pa2, pa3); pv_one<2>(o2, vb, pa0, pa1, pa2, pa3); pv_one<3>(o3, vb, pa0, pa1, pa2, pa3);
}
template <int LDQ, int LDK, int LDO>
__device__ __forceinline__ void attn_body(const bf16_t* __restrict__ Qb, const bf16_t* __restrict__ K0, const bf16_t* __restrict__ V0, int n0,
                                          const bf16_t* __restrict__ K1, const bf16_t* __restrict__ V1, int seq, float* __restrict__ Ob, bool combine, float lam, char* lds, int wv) {
  const int tid = tid_of(wv), wid = wv, lane = tid & 63, r32 = lane & 31, hi = lane >> 5;
  char* V_lds = lds; char* K_lds = lds + 2 * SHM_V;
  float* ws = (float*)(lds + 2 * SHM_V + 2 * SHM_K) + wid * 64; float* li_l = ws; float* al_l = ws + 32;
  float m_reg = -1e30f, l_reg = 0; f32x16 o0, o1, o2, o3; bf16x8 qr[8];
#pragma unroll
  for (int r = 0; r < 16; ++r) { o0[r] = 0.f; o1[r] = 0.f; o2[r] = 0.f; o3[r] = 0.f; }
  const bf16_t* Qw = Qb + (long)(wid * QBLK + r32) * LDQ + hi * 8;
#pragma unroll
  for (int d0 = 0; d0 < 8; ++d0) qr[d0] = *reinterpret_cast<const bf16x8*>(Qw + d0 * 16);
  const int sr = tid >> 4, sc = (tid & 15) * 8, vst0 = v_st(sr, sc), vst1 = v_st(32 + sr, sc);
  const int vb0 = (int)(uintptr_t)V_lds + v_rd_base(lane);
  bf16x8 sE_vs0, sE_vs1, sE_ks0, sE_ks1, sO_vs0, sO_vs1, sO_ks0, sO_ks1;
  const unsigned loff = (unsigned)(sr * LDK + sc) * 2u;
  constexpr long R32 = 32L * LDK * 2;
#define SLOAD(S, k0) do { const int k0_ = (k0); const bool s0_ = k0_ < n0; const long ko_ = (long)(s0_ ? k0_ : k0_ - n0) * (LDK * 2); \
    const char* kp_ = (const char*)(s0_ ? K0 : K1) + ko_; const char* vp_ = (const char*)(s0_ ? V0 : V1) + ko_; \
    S##_vs0 = *reinterpret_cast<const bf16x8*>(vp_ + loff); S##_vs1 = *reinterpret_cast<const bf16x8*>(vp_ + R32 + loff); \
    S##_ks0 = *reinterpret_cast<const bf16x8*>(kp_ + loff); S##_ks1 = *reinterpret_cast<const bf16x8*>(kp_ + R32 + loff); } while (0)
#define SWRITE(b, S) do { *(bf16x8*)(V_lds + (b) * SHM_V + vst0) = S##_vs0; *(bf16x8*)(V_lds + (b) * SHM_V + vst1) = S##_vs1; int kc = sc * 2; \
    *(bf16x8*)(K_lds + (b) * SHM_K + KSWZ(sr, kc)) = S##_ks0; *(bf16x8*)(K_lds + (b) * SHM_K + KSWZ(32 + sr, kc)) = S##_ks1; } while (0)
#define SWAIT() asm volatile("s_waitcnt vmcnt(4)" ::: "memory")
#define RESC(a) do { if (__any((a) < 1.f)) { if (hi == 0) al_l[r32] = (a); asm volatile("s_waitcnt lgkmcnt(0)" ::: "memory"); \
    _Pragma("unroll") for (int r = 0; r < 16; ++r) { const float al_ = al_l[crow(r, hi)]; o0[r] *= al_; o1[r] *= al_; o2[r] *= al_; o3[r] *= al_; } } } while (0)
  f32x16 pA0, pA1, pB0, pB1; float mnA, mnB, alA, alB; bf16x8 pa0, pa1, pa2, pa3; const int NT = seq / KVBLK;
  SLOAD(sE, 0); asm volatile("s_waitcnt vmcnt(0)" ::: "memory"); SWRITE(0, sE); __syncthreads();
  qkt(pA0, pA1, K_lds, qr, r32, hi); partialSM(pA0, pA1, m_reg, mnA, alA);
  SLOAD(sO, KVBLK); if (2 < NT) SLOAD(sE, 2 * KVBLK);
  SWAIT(); SWRITE(1, sO); __syncthreads();
  for (int j = 1; j + 1 < NT; j += 2) {
    SBAR(); qkt(pB0, pB1, K_lds + SHM_K, qr, r32, hi);
    finishSM(pA0, pA1, alA, l_reg, pa0, pa1, pa2, pa3); SBAR();
    SLOAD(sO, (j + 2) * KVBLK); SBAR();
    pv_d0(o0, o1, o2, o3, vb0, pa0, pa1, pa2, pa3); partialSM(pB0, pB1, m_reg, mnB, alB);
    __syncthreads(); SWAIT(); SWRITE(0, sE);
    RESC(alB); __syncthreads();
    SBAR(); qkt(pA0, pA1, K_lds, qr, r32, hi);
    finishSM(pB0, pB1, alB, l_reg, pa0, pa1, pa2, pa3); SBAR();
    if (j + 3 < NT) SLOAD(sE, (j + 3) * KVBLK); SBAR();
    pv_d0(o0, o1, o2, o3, vb0 + SHM_V, pa0, pa1, pa2, pa3); partialSM(pA0, pA1, m_reg, mnA, alA);
    __syncthreads(); SWAIT(); SWRITE(1, sO);
    RESC(alA); __syncthreads();
  }
  SBAR(); qkt(pB0, pB1, K_lds + SHM_K, qr, r32, hi);
  finishSM(pA0, pA1, alA, l_reg, pa0, pa1, pa2, pa3); SBAR();
  pv_d0(o0, o1, o2, o3, vb0, pa0, pa1, pa2, pa3); partialSM(pB0, pB1, m_reg, mnB, alB);
  __syncthreads(); RESC(alB);
  finishSM(pB0, pB1, alB, l_reg, pa0, pa1, pa2, pa3); SBAR();
  pv_d0(o0, o1, o2, o3, vb0 + SHM_V, pa0, pa1, pa2, pa3);
  if (hi == 0) li_l[r32] = l_reg; asm volatile("s_waitcnt lgkmcnt(0)" ::: "memory");
  float* Ow = Ob + (long)(wid * QBLK) * LDO;
#pragma unroll
  for (int r = 0; r < 16; ++r) { const int orow = crow(r, hi); const float rl = __builtin_amdgcn_rcpf(li_l[orow]); float* op = Ow + (long)orow * LDO + r32;
    if (!combine) { op[0] = o0[r] * rl; op[32] = o1[r] * rl; op[64] = o2[r] * rl; op[96] = o3[r] * rl; }
    else { op[0] = o0[r] * rl - lam * op[0]; op[32] = o1[r] * rl - lam * op[32]; op[64] = o2[r] * rl - lam * op[64]; op[96] = o3[r] * rl - lam * op[96]; } }
#undef SLOAD
#undef SWRITE
#undef SWAIT
#undef RESC
}

constexpr int A2_V = 0, A2_K = 4 * SHM_V, A2_W = A2_K + 2 * SHM_K, SHM_ATTN2 = A2_W + NW * 64 * 4;
template <int OFF> __device__ __forceinline__ bf16x8 lds_read128(int addr) { bf16x8 r; asm volatile("ds_read_b128 %0, %1 offset:%2" : "=&v"(r) : "v"(addr), "i"(OFF) : "memory"); return r; }
#define LGKM_WAIT(n) do { asm volatile("s_waitcnt lgkmcnt(" #n ")" ::: "memory"); SBAR(); } while (0)
template <int QD> __device__ __forceinline__ void qkt_pipe(f32x16& p0, f32x16& p1, int kb0, int kb1, int kb2, int kb3, int qdelta) {
#pragma unroll
  for (int r = 0; r < 16; ++r) { p0[r] = 0.f; p1[r] = 0.f; }
#define QK_RD(B0, B1, Q, base, hi128) do { B0 = lds_read128<(hi128) * 128>(base); B1 = lds_read128<(hi128) * 128 + 8192>(base); Q = lds_read128<(hi128) * 128 + QD>((base) + qdelta); } while (0)
#define QK_MM(B0, B1, Q) do { p0 = __builtin_amdgcn_mfma_f32_32x32x16_bf16(B0, Q, p0, 0, 0, 0); p1 = __builtin_amdgcn_mfma_f32_32x32x16_bf16(B1, Q, p1, 0, 0, 0); } while (0)
  bf16x8 a0, a1, aq, b0, b1, bq, c0, c1, cq;
  QK_RD(a0, a1, aq, kb0, 0); QK_RD(b0, b1, bq, kb1, 0);
  QK_RD(c0, c1, cq, kb2, 0); LGKM_WAIT(6); QK_MM(a0, a1, aq);
  QK_RD(a0, a1, aq, kb3, 0); LGKM_WAIT(6); QK_MM(b0, b1, bq);
  QK_RD(b0, b1, bq, kb0, 1); LGKM_WAIT(6); QK_MM(c0, c1, cq);
  QK_RD(c0, c1, cq, kb1, 1); LGKM_WAIT(6); QK_MM(a0, a1, aq);
  QK_RD(a0, a1, aq, kb2, 1); LGKM_WAIT(6); QK_MM(b0, b1, bq);
  QK_RD(b0, b1, bq, kb3, 1); LGKM_WAIT(6); QK_MM(c0, c1, cq);
  LGKM_WAIT(3); QK_MM(a0, a1, aq);
  LGKM_WAIT(0); QK_MM(b0, b1, bq);
#undef QK_RD
#undef QK_MM
}
__device__ __forceinline__ void qkt_pipe_qreg(f32x16& p0, f32x16& p1, int kb0, int kb1, int kb2, int kb3, const bf16x8 (&qr)[8]) {
#pragma unroll
  for (int r = 0; r < 16; ++r) { p0[r] = 0.f; p1[r] = 0.f; }
#define QK_RD(B0, B1, base, hi128) do { B0 = lds_read128<(hi128) * 128>(base); B1 = lds_read128<(hi128) * 128 + 8192>(base); } while (0)
#define QK_MM(B0, B1, Q) do { p0 = __builtin_amdgcn_mfma_f32_32x32x16_bf16(B0, Q, p0, 0, 0, 0); p1 = __builtin_amdgcn_mfma_f32_32x32x16_bf16(B1, Q, p1, 0, 0, 0); } while (0)
  bf16x8 a0, a1, b0, b1, c0, c1;
  QK_RD(a0, a1, kb0, 0); QK_RD(b0, b1, kb1, 0);
  QK_RD(c0, c1, kb2, 0); LGKM_WAIT(4); QK_MM(a0, a1, qr[0]);
  QK_RD(a0, a1, kb3, 0); LGKM_WAIT(4); QK_MM(b0, b1, qr[1]);
  QK_RD(b0, b1, kb0, 1); LGKM_WAIT(4); QK_MM(c0, c1, qr[2]);
  QK_RD(c0, c1, kb1, 1); LGKM_WAIT(4); QK_MM(a0, a1, qr[3]);
  QK_RD(a0, a1, kb2, 1); LGKM_WAIT(4); QK_MM(b0, b1, qr[4]);
  QK_RD(b0, b1, kb3, 1); LGKM_WAIT(4); QK_MM(c0, c1, qr[5]);
  LGKM_WAIT(2); QK_MM(a0, a1, qr[6]);
  LGKM_WAIT(0); QK_MM(b0, b1, qr[7]);
#undef QK_RD
#undef QK_MM
}
__device__ __forceinline__ void pv_pipe(f32x16& o0, f32x16& o1, f32x16& o2, f32x16& o3, f32x16& o4, f32x16& o5, f32x16& o6, f32x16& o7, int vb, bf16x8 pa0, bf16x8 pa1, bf16x8 pa2, bf16x8 pa3) {
#define PV_RD(X, H, D0) do { X##l0 = tr_read<(H) * SHM_V + v_rd_off(D0, 0, 0)>(vb); X##h0 = tr_read<(H) * SHM_V + v_rd_off(D0, 0, 1)>(vb); X##l1 = tr_read<(H) * SHM_V + v_rd_off(D0, 1, 0)>(vb); X##h1 = tr_read<(H) * SHM_V + v_rd_off(D0, 1, 1)>(vb); \
    X##l2 = tr_read<(H) * SHM_V + v_rd_off(D0, 2, 0)>(vb); X##h2 = tr_read<(H) * SHM_V + v_rd_off(D0, 2, 1)>(vb); X##l3 = tr_read<(H) * SHM_V + v_rd_off(D0, 3, 0)>(vb); X##h3 = tr_read<(H) * SHM_V + v_rd_off(D0, 3, 1)>(vb); } while (0)
#define PK(L, H) (bf16x8){L[0], L[1], L[2], L[3], H[0], H[1], H[2], H[3]}
#define PV_MM(X, OD) do { OD = __builtin_amdgcn_mfma_f32_32x32x16_bf16(pa0, PK(X##l0, X##h0), OD, 0, 0, 0); OD = __builtin_amdgcn_mfma_f32_32x32x16_bf16(pa1, PK(X##l1, X##h1), OD, 0, 0, 0); \
    OD = __builtin_amdgcn_mfma_f32_32x32x16_bf16(pa2, PK(X##l2, X##h2), OD, 0, 0, 0); OD = __builtin_amdgcn_mfma_f32_32x32x16_bf16(pa3, PK(X##l3, X##h3), OD, 0, 0, 0); } while (0)
  s16x4 El0, Eh0, El1, Eh1, El2, Eh2, El3, Eh3, Fl0, Fh0, Fl1, Fh1, Fl2, Fh2, Fl3, Fh3;
  PV_RD(E, 0, 0);
  PV_RD(F, 0, 1); LGKM_WAIT(8); PV_MM(E, o0);
  PV_RD(E, 0, 2); LGKM_WAIT(8); PV_MM(F, o1);
  PV_RD(F, 0, 3); LGKM_WAIT(8); PV_MM(E, o2);
  PV_RD(E, 1, 0); LGKM_WAIT(8); PV_MM(F, o3);
  PV_RD(F, 1, 1); LGKM_WAIT(8); PV_MM(E, o4);
  PV_RD(E, 1, 2); LGKM_WAIT(8); PV_MM(F, o5);
  PV_RD(F, 1, 3); LGKM_WAIT(8); PV_MM(E, o6);
  LGKM_WAIT(0); PV_MM(F, o7);
#undef PV_RD
#undef PK
#undef PV_MM
}
template <int LDQ, int LDK, int LDO>
__device__ __forceinline__ void attn_body256(const bf16_t* __restrict__ Qb, const bf16_t* __restrict__ K0, const bf16_t* __restrict__ V0, int n0,
                                             const bf16_t* __restrict__ K1, const bf16_t* __restrict__ V1, int seq, bf16_t* __restrict__ Ob, bool combine, float lam,
                                             bf16_t* __restrict__ Ao, const float* __restrict__ gain, float oml, char* lds, int wv) {
  const int tid = tid_of(wv), wid = wv, lane = tid & 63, r32 = lane & 31, hi = lane >> 5;
  constexpr int SHV2 = 2 * SHM_V;
  float* ws = (float*)(lds + A2_W) + wid * 64; float* li_l = ws; float* al_l = ws + 32;
  float m_reg = -1e30f, l_reg = 0; f32x16 o0, o1, o2, o3, o4, o5, o6, o7;
#pragma unroll
  for (int r = 0; r < 16; ++r) { o0[r] = 0.f; o1[r] = 0.f; o2[r] = 0.f; o3[r] = 0.f; o4[r] = 0.f; o5[r] = 0.f; o6[r] = 0.f; o7[r] = 0.f; }
  const int vb0 = A2_V + v_rd_base(lane);
  const int kbase0 = A2_K + KSWZ(r32, (0 * 16 + hi * 8) * 2), kbase1 = A2_K + KSWZ(r32, (1 * 16 + hi * 8) * 2), kbase2 = A2_K + KSWZ(r32, (2 * 16 + hi * 8) * 2), kbase3 = A2_K + KSWZ(r32, (3 * 16 + hi * 8) * 2);
  bf16x8 qr[8];
  { const bf16_t* Qw = Qb + (long)(wid * QBLK + r32) * LDQ + hi * 8;
#pragma unroll
    for (int d0 = 0; d0 < 8; ++d0) qr[d0] = *reinterpret_cast<const bf16x8*>(Qw + d0 * 16); }
  unsigned kof0, kof1, vof0, vof1;
  {
    const int kb = wid * 2;
    { const int row = kb * 4 + (lane >> 4), cbp = (lane & 15) * 16, cb = cbp ^ ((row & 7) << 4); kof0 = (unsigned)(row * LDK * 2 + cb); }
    { const int row = (kb + 1) * 4 + (lane >> 4), cbp = (lane & 15) * 16, cb = cbp ^ ((row & 7) << 4); kof1 = (unsigned)(row * LDK * 2 + cb); }
    { const int sub = kb * 2 + (lane >> 5), kk = (sub >> 2) * 8 + ((lane & 31) >> 2), k = (kk & ~0xC) | ((kk & 4) << 1) | ((kk & 8) >> 1), c = (sub & 3) * 32 + (lane & 3) * 8; vof0 = (unsigned)(k * LDK * 2 + c * 2); }
    { const int sub = (kb + 1) * 2 + (lane >> 5), kk = (sub >> 2) * 8 + ((lane & 31) >> 2), k = (kk & ~0xC) | ((kk & 4) << 1) | ((kk & 8) >> 1), c = (sub & 3) * 32 + (lane & 3) * 8; vof1 = (unsigned)(k * LDK * 2 + c * 2); }
  }
  LAS unsigned char* ldsl = (LAS unsigned char*)lds;
  const unsigned ldsw = (unsigned)wid * 2048u;
#define TILE_BASES(k0) const int k0_ = (k0); const bool s0_ = k0_ < n0; const long ko_ = (long)(s0_ ? k0_ : k0_ - n0) * (LDK * 2); \
    const char* kp_ = (const char*)(s0_ ? K0 : K1) + ko_; const char* vp_ = (const char*)(s0_ ? V0 : V1) + ko_;
#define DMA16(gp, loff) __builtin_amdgcn_global_load_lds((const unsigned*)(gp), (LAS unsigned*)(ldsl + (loff)), 16, 0, 0)
#define DMA_K(k0, b) do { TILE_BASES(k0) (void)vp_; const unsigned kb_ = A2_K + (b) * SHM_K + ldsw; DMA16(kp_ + kof0, kb_); DMA16(kp_ + kof1, kb_ + 1024); } while (0)
#define DMA_V(k0, b) do { TILE_BASES(k0) (void)kp_; const unsigned vb_ = A2_V + (b) * SHV2 + ldsw; \
    DMA16(vp_ + vof0, vb_); DMA16(vp_ + vof1, vb_ + 1024); DMA16(vp_ + 256 + vof0, vb_ + SHM_V); DMA16(vp_ + 256 + vof1, vb_ + SHM_V + 1024); } while (0)
#define ABAR() do { asm volatile("s_waitcnt lgkmcnt(0)" ::: "memory"); __builtin_amdgcn_s_barrier(); asm volatile("" ::: "memory"); } while (0)
  const int NT = seq / KVBLK;
  DMA_K(0, 0); DMA_V(0, 0);
  if (1 < NT) DMA_K(KVBLK, 1);
  asm volatile("s_waitcnt vmcnt(0)" ::: "memory");
  ABAR();
  const int h1 = wid >> 2;
  f32x16 p0, p1; float mn, al = 1.f; bf16x8 pa0, pa1, pa2, pa3;
#pragma unroll
  for (int r = 0; r < 16; ++r) { p0[r] = 0.f; p1[r] = 0.f; }
  pa0 = pa1 = pa2 = pa3 = (bf16x8){0, 0, 0, 0, 0, 0, 0, 0};
#define ATT_QK(jj) do { const int ko_ = ((jj) & 1) * SHM_K; qkt_pipe_qreg(p0, p1, kbase0 + ko_, kbase1 + ko_, kbase2 + ko_, kbase3 + ko_, qr); } while (0)
#define ATT_SM() do { partialSM(p0, p1, m_reg, mn, al); finishSM(p0, p1, al, l_reg, pa0, pa1, pa2, pa3); \
    if (__any(al < 1.f)) { if (hi == 0) al_l[r32] = al; asm volatile("s_waitcnt lgkmcnt(0)" ::: "memory"); \
      _Pragma("unroll") for (int r = 0; r < 16; ++r) { const float a_ = al_l[crow(r, hi)]; o0[r] *= a_; o1[r] *= a_; o2[r] *= a_; o3[r] *= a_; o4[r] *= a_; o5[r] *= a_; o6[r] *= a_; o7[r] *= a_; } } } while (0)
#define ATT_PV(jj) pv_pipe(o0, o1, o2, o3, o4, o5, o6, o7, vb0 + ((jj) & 1) * SHV2, pa0, pa1, pa2, pa3)
  if (h1) ABAR();
  for (int j = 0; j < NT; ++j) {
    const bool more = j + 1 < NT;
    if (more) { if (!h1) { if (j >= 1) DMA_K((j + 1) * KVBLK, (j + 1) & 1); } else DMA_V((j + 1) * KVBLK, (j + 1) & 1); }
    ATT_QK(j);
    ABAR();
    if (!h1 && more) DMA_V((j + 1) * KVBLK, (j + 1) & 1);
    ATT_SM();
    if (h1) asm volatile("s_waitcnt vmcnt(0)" ::: "memory");
    ABAR();
    if (h1 && j + 2 < NT) DMA_K((j + 2) * KVBLK, j & 1);
    ATT_PV(j);
    if (!h1) asm volatile("s_waitcnt vmcnt(0)" ::: "memory");
    ABAR();
  }
  if (!h1) ABAR();
#undef ATT_QK
#undef ATT_SM
#undef ATT_PV
  {
    if (hi == 0) li_l[r32] = l_reg; asm volatile("s_waitcnt lgkmcnt(0)" ::: "memory");
    bf16_t* Ow = Ob + (long)(wid * QBLK) * LDO;
    if (!combine) {
#pragma unroll
      for (int r = 0; r < 16; ++r) { const int orow = crow(r, hi); const float rl = __builtin_amdgcn_rcpf(li_l[orow]); bf16_t* op = Ow + (long)orow * LDO + r32;
        op[0] = (bf16_t)(pk_bf16(o0[r] * rl, 0.f) & 0xffffu); op[32] = (bf16_t)(pk_bf16(o1[r] * rl, 0.f) & 0xffffu); op[64] = (bf16_t)(pk_bf16(o2[r] * rl, 0.f) & 0xffffu); op[96] = (bf16_t)(pk_bf16(o3[r] * rl, 0.f) & 0xffffu);
        op[128] = (bf16_t)(pk_bf16(o4[r] * rl, 0.f) & 0xffffu); op[160] = (bf16_t)(pk_bf16(o5[r] * rl, 0.f) & 0xffffu); op[192] = (bf16_t)(pk_bf16(o6[r] * rl, 0.f) & 0xffffu); op[224] = (bf16_t)(pk_bf16(o7[r] * rl, 0.f) & 0xffffu); }
    } else {
      float gk[8];
#pragma unroll
      for (int k = 0; k < 8; ++k) gk[k] = gain[r32 + 32 * k] * oml;
      bf16_t* Aw = Ao + (long)(wid * QBLK) * LDO;
#pragma unroll
      for (int r = 0; r < 16; ++r) { const int orow = crow(r, hi); const float rl = __builtin_amdgcn_rcpf(li_l[orow]); const bf16_t* op = Ow + (long)orow * LDO + r32;
        const float d0 = o0[r] * rl - lam * bf2f(op[0]), d1 = o1[r] * rl - lam * bf2f(op[32]), d2 = o2[r] * rl - lam * bf2f(op[64]), d3 = o3[r] * rl - lam * bf2f(op[96]);
        const float d4 = o4[r] * rl - lam * bf2f(op[128]), d5 = o5[r] * rl - lam * bf2f(op[160]), d6 = o6[r] * rl - lam * bf2f(op[192]), d7 = o7[r] * rl - lam * bf2f(op[224]);
        float ss = ((d0 * d0 + d1 * d1) + (d2 * d2 + d3 * d3)) + ((d4 * d4 + d5 * d5) + (d6 * d6 + d7 * d7));
        ss = sum16(ss);
        ss += __builtin_bit_cast(float, __builtin_amdgcn_ds_swizzle(__builtin_bit_cast(int, ss), 0x401F));
        const float rs = 1.0f / sqrtf(ss * (1.0f / 256.0f) + 1e-6f);
        bf16_t* ap = Aw + (long)orow * LDO + r32;
        ap[0] = (bf16_t)(pk_bf16(d0 * rs * gk[0], 0.f) & 0xffffu); ap[32] = (bf16_t)(pk_bf16(d1 * rs * gk[1], 0.f) & 0xffffu); ap[64] = (bf16_t)(pk_bf16(d2 * rs * gk[2], 0.f) & 0xffffu); ap[96] = (bf16_t)(pk_bf16(d3 * rs * gk[3], 0.f) & 0xffffu);
        ap[128] = (bf16_t)(pk_bf16(d4 * rs * gk[4], 0.f) & 0xffffu); ap[160] = (bf16_t)(pk_bf16(d5 * rs * gk[5], 0.f) & 0xffffu); ap[192] = (bf16_t)(pk_bf16(d6 * rs * gk[6], 0.f) & 0xffffu); ap[224] = (bf16_t)(pk_bf16(d7 * rs * gk[7], 0.f) & 0xffffu); }
    }
  }
#undef TILE_BASES
#undef DMA16
#undef DMA_K
#undef DMA_V
#undef ABAR
}
#undef SBAR
}


namespace scan {
constexpr int KIMG = 0, QIMG = 16384, CH0 = 32768, CHSZ = 61440;
constexpr int VIMG = 0, AMAT = 16384, WN = 16384, TP = 32768, TPP = 40960, QKM = 49152, A21I = 57344, T22I = 59392;
constexpr int VEC0 = CH0 + 2 * CHSZ, VECSZ = 1280;
static_assert(VEC0 + 2 * VECSZ <= MISC_OFF, "scan LDS map");
__device__ __forceinline__ int crow(int r, int hi) { return (r & 3) + 8 * (r >> 2) + 4 * hi; }
__device__ __forceinline__ unsigned off_b(unsigned row, unsigned ch) { return 256u * row + 16u * (ch ^ (((row & 3) << 2) | ((row >> 2) & 3))); }
__device__ __forceinline__ unsigned off64(unsigned row, unsigned ch) { return 128u * row + 16u * (ch ^ ((row >> 1) & 7)); }
__device__ __forceinline__ bf16x8 row_frag_b(const LAS unsigned char* img, int lane, int rb, int s) { return *(const LAS bf16x8*)(img + off_b((lane & 31) + 32 * rb, 2 * s + (lane >> 5))); }
__device__ __forceinline__ unsigned off32(unsigned row, unsigned ch) { return 64u * row + 16u * (ch ^ ((row >> 2) & 3)); }
__device__ __forceinline__ bf16x8 row_frag_32(const LAS unsigned char* img, int lane, int s) { return *(const LAS bf16x8*)(img + off32(lane & 31, 2 * s + (lane >> 5))); }
__device__ __forceinline__ bf16x8 row_frag_64(const LAS unsigned char* img, int lane, int rb, int s) { return *(const LAS bf16x8*)(img + off64((lane & 31) + 32 * rb, 2 * s + (lane >> 5))); }
__device__ __forceinline__ bf16x8 tr_frag_b(const LAS unsigned char* img, int lane, int c, int ks) {
    const unsigned h = lane >> 5, blk = (lane >> 4) & 1, q = (lane & 15) >> 2, p = lane & 3;
    const unsigned a0 = off_b(16 * ks + 8 * h + q, 4 * c + 2 * blk + (p >> 1)) + 8 * (p & 1);
    const unsigned a1 = off_b(16 * ks + 8 * h + 4 + q, 4 * c + 2 * blk + (p >> 1)) + 8 * (p & 1);
    const s16x4 lo = __builtin_amdgcn_ds_read_tr16_b64_v4i16((LAS s16x4*)(img + a0)), hi2 = __builtin_amdgcn_ds_read_tr16_b64_v4i16((LAS s16x4*)(img + a1));
    return (bf16x8){lo[0], lo[1], lo[2], lo[3], hi2[0], hi2[1], hi2[2], hi2[3]};
}
template <int BASE> __device__ __forceinline__ bf16x8 pk4(const f32x16& P) {
    const unsigned a0 = pk_bf16(P[BASE + 0], P[BASE + 1]), a1 = pk_bf16(P[BASE + 2], P[BASE + 3]), b0 = pk_bf16(P[BASE + 4], P[BASE + 5]), b1 = pk_bf16(P[BASE + 6], P[BASE + 7]);
    const auto r0 = __builtin_amdgcn_permlane32_swap(a0, b0, false, false); const auto r1 = __builtin_amdgcn_permlane32_swap(a1, b1, false, false);
    const u32x4 w = {r0[0], r1[0], r0[1], r1[1]}; return __builtin_bit_cast(bf16x8, w);
}
#define MFMA32(a, b, c) __builtin_amdgcn_mfma_f32_32x32x16_bf16((a), (b), (c), 0, 0, 0)
__device__ __forceinline__ void zero16(f32x16& x) {
#pragma unroll
    for (int r = 0; r < 16; ++r) x[r] = 0.f;
}

__device__ __forceinline__ u32x4 l2n8(const u32x4 q, float scale) {
    const float y0 = bf_lo(q.x), y1 = bf_hi(q.x), y2 = bf_lo(q.y), y3 = bf_hi(q.y), y4 = bf_lo(q.z), y5 = bf_hi(q.z), y6 = bf_lo(q.w), y7 = bf_hi(q.w);
    float ss = ((y0 * y0 + y1 * y1) + (y2 * y2 + y3 * y3)) + ((y4 * y4 + y5 * y5) + (y6 * y6 + y7 * y7));
    ss = sum16(ss);
    const float rn = scale * __builtin_amdgcn_rsqf(ss + EPS);
    u32x4 o; o.x = pk_bf16(y0 * rn, y1 * rn); o.y = pk_bf16(y2 * rn, y3 * rn); o.z = pk_bf16(y4 * rn, y5 * rn); o.w = pk_bf16(y6 * rn, y7 * rn); return o;
}
__device__ __forceinline__ void gdn_scan(const bf16_t* __restrict__ QN, const bf16_t* __restrict__ KN, const bf16_t* __restrict__ VN, const float* __restrict__ BETA, const float* __restrict__ GG,
                                         bf16_t* __restrict__ OF, bf16_t* __restrict__ OB, bool ctx_out, LAS unsigned char* lds, int bid, int G, int wave) {
    const int cl = wave >> 2, wq = wave & 3;
#define LANES const int tid = tid_of(wave), lane = tid & 63, hi = lane >> 5, r32 = lane & 31; (void)hi; (void)r32;
    LAS unsigned char* chb = lds + CH0 + cl * CHSZ;
    LAS float* vec = (LAS float*)(lds + VEC0 + cl * VECSZ);
    for (int unit = bid; unit < 256; unit += G) {
        const int dir = unit & 1, qh = (unit >> 1) & 15, b = unit >> 5, hh = 2 * qh + cl;
        bf16_t* OUT = dir ? OB : OF;
        f32x16 S0, S1, S2, S3;
        zero16(S0); zero16(S1); zero16(S2); zero16(S3);
        u32x4 pk0, pk1, pq0, pq1, pv0, pv1, pv2, pv3; float pbt = 0.f, pgm = 0.f;
#define SCAN_LOAD(nn) do { LANES const int L_ = (nn) < 4 ? CTXL : SEQ, cn_ = (nn) < 4 ? (nn) : (nn) - 4, rb_ = (nn) < 4 ? NLAT + b * CTXL : b * SEQ; \
            const int r0_ = rb_ + (dir ? L_ - 1 - 64 * cn_ : 64 * cn_), rs_ = dir ? -1 : 1; \
            const int e0 = tid, e1 = tid + 512, i0 = e0 >> 4, i1 = e1 >> 4, c0 = e0 & 15, c1 = e1 & 15, t2 = tid & 255; \
            pk0 = *(const u32x4*)(KN + (size_t)(r0_ + rs_ * i0) * 2048 + qh * 128 + c0 * 8); pk1 = *(const u32x4*)(KN + (size_t)(r0_ + rs_ * i1) * 2048 + qh * 128 + c1 * 8); \
            if (wq == 0) { const size_t gi = (size_t)(r0_ + rs_ * lane) * 64 + dir * 32 + hh; pbt = BETA[gi]; pgm = GG[gi]; } } while (0)
#define SCAN_LOAD_V(nn) do { LANES const int L_ = (nn) < 4 ? CTXL : SEQ, cn_ = (nn) < 4 ? (nn) : (nn) - 4, rb_ = (nn) < 4 ? NLAT + b * CTXL : b * SEQ; \
            const int r0_ = rb_ + (dir ? L_ - 1 - 64 * cn_ : 64 * cn_), rs_ = dir ? -1 : 1; const int t2 = tid & 255; \
            { const int e0 = tid, e1 = tid + 512, i0 = e0 >> 4, i1 = e1 >> 4, c0 = e0 & 15, c1 = e1 & 15;        \
              pq0 = *(const u32x4*)(QN + (size_t)(r0_ + rs_ * i0) * 2048 + qh * 128 + c0 * 8); pq1 = *(const u32x4*)(QN + (size_t)(r0_ + rs_ * i1) * 2048 + qh * 128 + c1 * 8); } \
            const bf16_t* vb = VN + hh * 128 + (t2 & 15) * 8; \
            pv0 = *(const u32x4*)(vb + (size_t)(r0_ + rs_ * ((t2 >> 4))) * 4096); pv1 = *(const u32x4*)(vb + (size_t)(r0_ + rs_ * ((t2 >> 4) + 16)) * 4096); \
            pv2 = *(const u32x4*)(vb + (size_t)(r0_ + rs_ * ((t2 >> 4) + 32)) * 4096); pv3 = *(const u32x4*)(vb + (size_t)(r0_ + rs_ * ((t2 >> 4) + 48)) * 4096); } while (0)
        SCAN_LOAD(0);
        for (int n = 0; n < 36; ++n) {
            SCAN_LOAD_V(n);
            const int L = n < 4 ? CTXL : SEQ, cn = n < 4 ? n : n - 4, rbase = n < 4 ? NLAT + b * CTXL : b * SEQ;
            const bool want = (n >= 4) || ctx_out;
            const int r0 = rbase + (dir ? L - 1 - 64 * cn : 64 * cn), rs = dir ? -1 : 1;
            { LANES
                if (wq == 0) {
                    const float bt = pbt; float gm = pgm;
                    gm += dpp_f<0x111>(gm); gm += dpp_f<0x112>(gm); gm += dpp_f<0x114>(gm); gm += dpp_f<0x118>(gm);
                    { const float t0 = lane_bcast(gm, 15), t1 = lane_bcast(gm, 31), t2 = lane_bcast(gm, 47); const int rw = lane >> 4;
                      gm += (rw > 0 ? t0 : 0.f) + (rw > 1 ? t1 : 0.f) + (rw > 2 ? t2 : 0.f); }
                    const float glast = lane_bcast(gm, 63);
                    vec[lane] = gm; vec[64 + lane] = __expf(gm); vec[128 + lane] = bt; vec[192 + lane] = __expf(glast - gm);
                    if (lane == 0) vec[256] = __expf(glast);
                }
                { const int e0 = tid, e1 = tid + 512, t2 = tid & 255;
                  pk0 = l2n8(pk0, 1.0f); pk1 = l2n8(pk1, 1.0f);
                  *(LAS u32x4*)(lds + KIMG + off_b(e0 >> 4, e0 & 15)) = pk0; *(LAS u32x4*)(lds + KIMG + off_b(e1 >> 4, e1 & 15)) = pk1;
                  (void)t2; }
            }
            __syncthreads();
#define SCAN_BLOCK(WHICH) do { LANES \
                const int blk = wq - 1, rb = blk > 0 ? 1 : 0, cb = blk > 1 ? 1 : 0; \
                f32x16 P; zero16(P); \
                const LAS unsigned char* aimg = lds + ((WHICH) ? QIMG : KIMG); \
                _Pragma("unroll") for (int s = 0; s < 8; ++s) P = MFMA32(row_frag_b(aimg, lane, rb, s), row_frag_b(lds + KIMG, lane, cb, s), P); \
                const int j = 32 * cb + r32; const float gj = vec[j]; \
                  \
                const unsigned jc = (unsigned)j >> 3, jb = (unsigned)(j & 7) * 2u, ib = 32u * rb + 4u * hi; \
                const unsigned abase = (ib * 64u + (unsigned)j) * 4u; \
                const unsigned x21[2] = {256u * hi + 16u * (jc ^ (unsigned)(hi & 3)) + jb, 256u * hi + 16u * (jc ^ (unsigned)((hi + 2) & 3)) + jb};                         \
                const unsigned yq[4] = {128u * ib + 16u * (jc ^ (unsigned)((2 * hi + 0) & 7)) + jb, 128u * ib + 16u * (jc ^ (unsigned)((2 * hi + 1) & 7)) + jb, \
                                        128u * ib + 16u * (jc ^ (unsigned)((2 * hi + 4) & 7)) + jb, 128u * ib + 16u * (jc ^ (unsigned)((2 * hi + 5) & 7)) + jb};     \
                _Pragma("unroll") for (int r = 0; r < 16; r += 2) { const int k = (r & 3) + 8 * (r >> 2); const int i = 32 * rb + crow(r, hi), i1 = i + 1; const float dec = __expf(vec[i] - gj), dec1 = __expf(vec[i1] - gj); \
                    if ((WHICH) == 0) { const float a = vec[128 + i] * P[r] * dec, a1 = vec[128 + i1] * P[r + 1] * dec1;        \
                        if (rb == cb) { *(LAS float*)(chb + AMAT + abase + 256u * k) = a; *(LAS float*)(chb + AMAT + abase + 256u * (k + 1)) = a1; } \
                        else { const unsigned w = pk_bf16(a, a1); const unsigned o = x21[(r >> 2) & 1] + 64u * k; *(LAS bf16_t*)(chb + A21I + o) = (bf16_t)(w & 0xffffu); *(LAS bf16_t*)(chb + A21I + o + 64u) = (bf16_t)(w >> 16); } } \
                    else { const float a = (i >= j) ? P[r] * dec : 0.f, a1 = (i1 >= j) ? P[r + 1] * dec1 : 0.f; const unsigned w = pk_bf16(a, a1); const unsigned o = yq[((r & 3) >> 1) + 2 * ((r >> 2) & 1)] + 128u * k; \
                        *(LAS bf16_t*)(chb + QKM + o) = (bf16_t)(w & 0xffffu); *(LAS bf16_t*)(chb + QKM + o + 128u) = (bf16_t)(w >> 16); } } } while (0)
            bf16x8 ksf0, ksf1, ksf2, ksf3;
            if (wq >= 1) SCAN_BLOCK(0);
            if (wq == 0) { LANES
                const bf16x8 tf0 = pk4<0>(S0), tf1 = pk4<8>(S0), tf2 = pk4<0>(S1), tf3 = pk4<8>(S1), tf4 = pk4<0>(S2), tf5 = pk4<8>(S2), tf6 = pk4<0>(S3), tf7 = pk4<8>(S3);
#define TF(k) ((k) == 0 ? tf0 : (k) == 1 ? tf1 : (k) == 2 ? tf2 : (k) == 3 ? tf3 : (k) == 4 ? tf4 : (k) == 5 ? tf5 : (k) == 6 ? tf6 : tf7)
                f32x16 K0, K1; zero16(K0); zero16(K1);
#pragma unroll
                for (int ks = 0; ks < 8; ++ks) { K0 = MFMA32(row_frag_b(lds + KIMG, lane, 0, ks), TF(ks), K0); K1 = MFMA32(row_frag_b(lds + KIMG, lane, 1, ks), TF(ks), K1); }
#undef TF
#pragma unroll
                for (int r = 0; r < 16; ++r) { K0[r] = -K0[r]; K1[r] = -K1[r]; }
                ksf0 = pk4<0>(K0); ksf1 = pk4<8>(K0); ksf2 = pk4<0>(K1); ksf3 = pk4<8>(K1);
            }
            { LANES const int t2 = tid & 255;
              { const int e0 = tid, e1 = tid + 512; pq0 = l2n8(pq0, 0.08838834764831845f); pq1 = l2n8(pq1, 0.08838834764831845f);
                *(LAS u32x4*)(lds + QIMG + off_b(e0 >> 4, e0 & 15)) = pq0; *(LAS u32x4*)(lds + QIMG + off_b(e1 >> 4, e1 & 15)) = pq1; }
              *(LAS u32x4*)(chb + VIMG + off_b((t2 >> 4), t2 & 15)) = pv0; *(LAS u32x4*)(chb + VIMG + off_b((t2 >> 4) + 16, t2 & 15)) = pv1;
              *(LAS u32x4*)(chb + VIMG + off_b((t2 >> 4) + 32, t2 & 15)) = pv2; *(LAS u32x4*)(chb + VIMG + off_b((t2 >> 4) + 48, t2 & 15)) = pv3; }
            __syncthreads();
            if (wq >= 1) SCAN_BLOCK(1);
            if (wq >= 1) { LANES
                const bf16x8 tf0 = pk4<0>(S0), tf1 = pk4<8>(S0), tf2 = pk4<0>(S1), tf3 = pk4<8>(S1), tf4 = pk4<0>(S2), tf5 = pk4<8>(S2), tf6 = pk4<0>(S3), tf7 = pk4<8>(S3);
#define TF(k) ((k) == 0 ? tf0 : (k) == 1 ? tf1 : (k) == 2 ? tf2 : (k) == 3 ? tf3 : (k) == 4 ? tf4 : (k) == 5 ? tf5 : (k) == 6 ? tf6 : tf7)
                f32x16 K0, K1; zero16(K0); zero16(K1);
#pragma unroll
                for (int ks = 0; ks < 8; ++ks) { K0 = MFMA32(row_frag_b(lds + KIMG, lane, 0, ks), TF(ks), K0); K1 = MFMA32(row_frag_b(lds + KIMG, lane, 1, ks), TF(ks), K1); }
#undef TF
#pragma unroll
                for (int r = 0; r < 16; ++r) { K0[r] = -K0[r]; K1[r] = -K1[r]; }
                ksf0 = pk4<0>(K0); ksf1 = pk4<8>(K0); ksf2 = pk4<0>(K1); ksf3 = pk4<8>(K1);
            }
#undef SCAN_BLOCK
            if (wq == 0) { LANES
                const int hb = hi, c = r32;
                const LAS float* am = (const LAS float*)(chb + AMAT) + hb * (32 * 64 + 32);
                float t[32];
                typedef float f32x2v __attribute__((ext_vector_type(2)));
                f32x2v tp[16];
                f32x4 ab[2][8];
#pragma unroll
                for (int i = 0; i < 32; ++i) {
                    if (i + 1 < 32) {
#pragma unroll
                        for (int q4 = 0; q4 < 8; ++q4) if (q4 < (i + 1 + 3) / 4) ab[(i + 1) & 1][q4] = *(const LAS f32x4*)(am + (i + 1) * 64 + q4 * 4);
                    }
                    f32x2v acc2 = {(c == i) ? 1.f : 0.f, 0.f};
#pragma unroll
                    for (int k = 0; k < 16; ++k) if (2 * k + 1 < i) { const f32x4 a4 = ab[i & 1][k >> 1]; const f32x2v a2 = (k & 1) ? (f32x2v){a4[2], a4[3]} : (f32x2v){a4[0], a4[1]}; acc2 -= a2 * tp[k]; }
                    float ti = acc2[0] + acc2[1];
                    if (i & 1) ti -= ab[i & 1][(i - 1) >> 2][(i - 1) & 3] * tp[(i - 1) >> 1][0];
                    asm volatile("" : "+v"(ti) :: "memory");
                    tp[i >> 1][i & 1] = ti; t[i] = ti;
                }
                const float bc = vec[128 + 32 * hb + c], ec = vec[64 + 32 * hb + c];
                {
                    const unsigned ch = (unsigned)(32 * hb + c) >> 3, cb2 = (c & 7) * 2, rowb = 128u * 32u * hb;
                    unsigned ox[8];
#pragma unroll
                    for (int k = 0; k < 8; ++k) ox[k] = rowb + 16u * (ch ^ (unsigned)k) + cb2;
#pragma unroll
                    for (int i = 0; i < 32; ++i) { const float v1 = t[i] * bc, v2 = v1 * ec; const unsigned w = pk_bf16(v1, v2); const unsigned o = ox[(i >> 1) & 7] + 128u * i;
                        *(LAS bf16_t*)(chb + TP + o) = (bf16_t)(w & 0xffffu); *(LAS bf16_t*)(chb + TPP + o) = (bf16_t)(w >> 16); }
                    if (hb) {
#pragma unroll
                        for (int i = 0; i < 32; i += 2) { const unsigned w = pk_bf16(t[i], t[i + 1]);
                            *(LAS bf16_t*)(chb + T22I + off32(i, c >> 3) + (c & 7) * 2) = (bf16_t)(w & 0xffffu); *(LAS bf16_t*)(chb + T22I + off32(i + 1, c >> 3) + (c & 7) * 2) = (bf16_t)(w >> 16); }
                    }
                }
                bf16x8 bf0, bf1;
                {
                    u32x4 w0, w1;
#pragma unroll
                    for (int e = 0; e < 4; ++e) {
                        const unsigned lo0 = pk_bf16(t[2 * e], t[2 * e + 1]), hi0 = pk_bf16(t[8 + 2 * e], t[9 + 2 * e]);
                        const unsigned lo1 = pk_bf16(t[16 + 2 * e], t[17 + 2 * e]), hi1 = pk_bf16(t[24 + 2 * e], t[25 + 2 * e]);
                        const auto s0 = __builtin_amdgcn_permlane32_swap(hi0, hi0, false, false); const auto s1 = __builtin_amdgcn_permlane32_swap(hi1, hi1, false, false);
                        w0[e] = hb ? s0[0] : lo0; w1[e] = hb ? s1[0] : lo1;
                    }
                    bf0 = __builtin_bit_cast(bf16x8, w0); bf1 = __builtin_bit_cast(bf16x8, w1);
                }
                f32x16 M1; zero16(M1);
                M1 = MFMA32(row_frag_32(chb + A21I, lane, 0), bf0, M1); M1 = MFMA32(row_frag_32(chb + A21I, lane, 1), bf1, M1);
                const bf16x8 m0 = pk4<0>(M1), m1 = pk4<8>(M1);
                f32x16 M2; zero16(M2);
                M2 = MFMA32(row_frag_32(chb + T22I, lane, 0), m0, M2); M2 = MFMA32(row_frag_32(chb + T22I, lane, 1), m1, M2);
                const float bc0 = vec[128 + c], ec0 = vec[64 + c];
#pragma unroll
                for (int r = 0; r < 16; ++r) { const float v1 = -M2[r] * bc0, v2 = v1 * ec0; const unsigned w = pk_bf16(v1, v2); const unsigned o = off64(32 + crow(r, hi), c >> 3) + (c & 7) * 2;
                    *(LAS bf16_t*)(chb + TP + o) = (bf16_t)(w & 0xffffu); *(LAS bf16_t*)(chb + TPP + o) = (bf16_t)(w >> 16); }
            }
            __syncthreads();
            f32x16 V0, V1;
            { LANES
                zero16(V0); zero16(V1);
#define KSF(k) ((k) == 0 ? ksf0 : (k) == 1 ? ksf1 : (k) == 2 ? ksf2 : ksf3)
#pragma unroll
                for (int ks = 0; ks < 4; ++ks) {
                    const bf16x8 vf = tr_frag_b(chb + VIMG, lane, wq, ks);
                    if (ks < 2) { V0 = MFMA32(row_frag_64(chb + TP, lane, 0, ks), vf, V0); V0 = MFMA32(row_frag_64(chb + TPP, lane, 0, ks), KSF(ks), V0); }
                    V1 = MFMA32(row_frag_64(chb + TP, lane, 1, ks), vf, V1); V1 = MFMA32(row_frag_64(chb + TPP, lane, 1, ks), KSF(ks), V1);
                }
#undef KSF
            }
            if (n + 1 < 36) SCAN_LOAD(n + 1);
            { LANES
                const bf16x8 sf0 = pk4<0>(S0), sf1 = pk4<8>(S0), sf2 = pk4<0>(S1), sf3 = pk4<8>(S1), sf4 = pk4<0>(S2), sf5 = pk4<8>(S2), sf6 = pk4<0>(S3), sf7 = pk4<8>(S3);
#define SF(k) ((k) == 0 ? sf0 : (k) == 1 ? sf1 : (k) == 2 ? sf2 : (k) == 3 ? sf3 : (k) == 4 ? sf4 : (k) == 5 ? sf5 : (k) == 6 ? sf6 : sf7)
                if (want) { LANES
                    f32x16 O0, O1; zero16(O0); zero16(O1);
#pragma unroll
                    for (int ks = 0; ks < 8; ++ks) { O0 = MFMA32(row_frag_b(lds + QIMG, lane, 0, ks), SF(ks), O0); O1 = MFMA32(row_frag_b(lds + QIMG, lane, 1, ks), SF(ks), O1); }
#pragma unroll
                    for (int r = 0; r < 16; ++r) { O0[r] *= vec[64 + crow(r, hi)]; O1[r] *= vec[64 + 32 + crow(r, hi)]; }
                    const bf16x8 vf0 = pk4<0>(V0), vf1 = pk4<8>(V0), vf2 = pk4<0>(V1), vf3 = pk4<8>(V1);
                    O0 = MFMA32(row_frag_64(chb + QKM, lane, 0, 0), vf0, O0); O0 = MFMA32(row_frag_64(chb + QKM, lane, 0, 1), vf1, O0);
                    O1 = MFMA32(row_frag_64(chb + QKM, lane, 1, 0), vf0, O1); O1 = MFMA32(row_frag_64(chb + QKM, lane, 1, 1), vf1, O1);
                    O1 = MFMA32(row_frag_64(chb + QKM, lane, 1, 2), vf2, O1); O1 = MFMA32(row_frag_64(chb + QKM, lane, 1, 3), vf3, O1);
                    const unsigned ob0 = (unsigned)((r0 + rs * 4 * hi) * 4096 + hh * 128 + 32 * wq + r32) * 2u; const int rstep = rs * 8192;
#pragma unroll
                    for (int r = 0; r < 16; ++r) { const int k = (r & 3) + 8 * (r >> 2); const unsigned w = pk_bf16(O0[r], O1[r]);
                        *(bf16_t*)((char*)OUT + (ob0 + (unsigned)(k * rstep))) = (bf16_t)(w & 0xffffu); *(bf16_t*)((char*)OUT + (ob0 + (unsigned)((32 + k) * rstep))) = (bf16_t)(w >> 16); }
                }
#undef SF
            }
            { LANES
                const float gl = vec[256];
#pragma unroll
                for (int r = 0; r < 16; ++r) { V0[r] *= vec[192 + crow(r, hi)]; V1[r] *= vec[192 + 32 + crow(r, hi)]; S0[r] *= gl; S1[r] *= gl; S2[r] *= gl; S3[r] *= gl; }
                const bf16x8 vf0 = pk4<0>(V0), vf1 = pk4<8>(V0), vf2 = pk4<0>(V1), vf3 = pk4<8>(V1);
#define VF(k) ((k) == 0 ? vf0 : (k) == 1 ? vf1 : (k) == 2 ? vf2 : vf3)
#pragma unroll
                for (int ks = 0; ks < 4; ++ks) {
                    S0 = MFMA32(tr_frag_b(lds + KIMG, lane, 0, ks), VF(ks), S0); S1 = MFMA32(tr_frag_b(lds + KIMG, lane, 1, ks), VF(ks), S1);
                    S2 = MFMA32(tr_frag_b(lds + KIMG, lane, 2, ks), VF(ks), S2); S3 = MFMA32(tr_frag_b(lds + KIMG, lane, 3, ks), VF(ks), S3);
                }
#undef VF
            }
            __syncthreads();
        }
    }
}
#undef MFMA32
#undef SCAN_LOAD
#undef SCAN_LOAD_V
#undef LANES
}

struct Args { const float* in[22]; float* out; unsigned char* ws; int ph_lo, ph_hi, li, pad; };
enum { IN_X = 0, IN_C, IN_CTX, IN_CCTX, IN_WMOD, IN_BMOD, IN_NMIX, IN_NFFN, IN_DAQKV, IN_DALAM, IN_DAGAIN, IN_DAWO, IN_GWIN, IN_GCONV, IN_GALOG, IN_GDT, IN_GGAIN, IN_GWO, IN_FUP, IN_FCONV, IN_FDN, IN_FNORM };
constexpr int NWAVES = 8, NTHR = 512;

__device__ __forceinline__ int rope_dst(int n) { const int d = n & 127, a = d >> 6, j = d & 63, hi = j >> 5, f = j & 31; return (n & ~127) + a * 64 + 2 * f + hi; }
__device__ __forceinline__ int up_dst(int n) { const int half = n >= DFF ? 1 : 0, rem = n - half * DFF; return (rem >> 7) * 256 + half * 128 + (rem & 127); }
__device__ __forceinline__ void transpose_item(const float* W, int K, int N, bf16_t* WT, int ropelim, LAS float* scr, int item, int lane) {
    const int nblk = N / 32, kb = item / nblk, nb = item % nblk, k0 = 64 * kb, n0 = 32 * nb;
#pragma unroll 8
    for (int i = 0; i < 32; ++i) { const int kk = 2 * i + (lane >> 5); scr[kk * 33 + (lane & 31)] = W[(size_t)(k0 + kk) * N + n0 + (lane & 31)]; }
    asm volatile("s_waitcnt lgkmcnt(0)" ::: "memory");
    const int c = lane & 7;
#pragma unroll
    for (int j = 0; j < 4; ++j) { const int n = (lane >> 3) + 8 * j; const LAS float* s = scr + (8 * c) * 33 + n;
        u32x4 o; o.x = pk_bf16(s[0 * 33], s[1 * 33]); o.y = pk_bf16(s[2 * 33], s[3 * 33]); o.z = pk_bf16(s[4 * 33], s[5 * 33]); o.w = pk_bf16(s[6 * 33], s[7 * 33]);
        const int ns = n0 + n, nd = ropelim < 0 ? up_dst(ns) : (ns < ropelim ? rope_dst(ns) : ns);
        *(u32x4*)(WT + (size_t)nd * K + k0 + 8 * c) = o; }
    asm volatile("s_waitcnt lgkmcnt(0)" ::: "memory");
}
__device__ __forceinline__ void transpose_matrix(const float* W, int K, int N, bf16_t* WT, int ropelim, LAS float* scr, int gw, int NGW, int lane) {
    const int nitems = (K / 64) * (N / 32);
    for (int it = gw; it < nitems; it += NGW) transpose_item(W, K, N, WT, ropelim, scr, it, lane);
}

__device__ __forceinline__ void norm_row_load(const float* inL, const float* inC, const bf16_t* X, bool from_in, int row, int lane, f32x4 (&v)[8]) {
    if (from_in) {
        const f32x4* xs = (const f32x4*)(row < NLAT ? inL + (size_t)row * DM : inC + (size_t)(row - NLAT) * DM) + lane;
#pragma unroll
        for (int j = 0; j < 8; ++j) v[j] = xs[64 * j];
    } else {
        const u32x2* xs = (const u32x2*)(X + (size_t)row * DM) + lane;
        u32x2 q[8];
#pragma unroll
        for (int j = 0; j < 8; ++j) q[j] = xs[64 * j];
#pragma unroll
        for (int j = 0; j < 8; ++j) v[j] = (f32x4){xs_lo(q[j].x), xs_hi(q[j].x), xs_lo(q[j].y), xs_hi(q[j].y)};
    }
}
__device__ __forceinline__ void norm_row_finish(f32x4 (&v)[8], bf16_t* X, bool from_in, const float* w, const float* mod_shift, const float* mod_scale, bf16_t* H, int row, const float* part, const float* pgate, int lane) {
    const int mr = row < NLAT ? (row >> 11) : 8;
    const bool fold = part != nullptr && row >= NLAT;
    if (fold) {
        const int tr = (row - NLAT) >> 8, rr = (row - NLAT) & 255;
#pragma unroll
        for (int j = 0; j < 8; ++j) {
            const float* pp = part + ((size_t)((tr * 8 + j) * 4) * 256 + rr) * 256 + lane * 4;
            const f32x4 p0 = *(const f32x4*)pp, p1 = *(const f32x4*)(pp + 65536), p2 = *(const f32x4*)(pp + 2 * 65536), p3 = *(const f32x4*)(pp + 3 * 65536);
            const f32x4 gt = *((const f32x4*)(pgate + (size_t)8 * MODW) + lane + 64 * j);
            v[j] += gt * (((p0 + p1) + p2) + p3);
        }
    }
    if (fold || from_in) {
        u32x2* xr = (u32x2*)(X + (size_t)row * DM) + lane;
#pragma unroll
        for (int j = 0; j < 8; ++j) { u32x2 o; o.x = pk_xs(v[j][0], v[j][1]); o.y = pk_xs(v[j][2], v[j][3]); xr[64 * j] = o;
            v[j] = (f32x4){xs_lo(o.x), xs_hi(o.x), xs_lo(o.y), xs_hi(o.y)}; }
    }
    float s = 0.f;
#pragma unroll
    for (int j = 0; j < 8; ++j) s += (v[j][0] * v[j][0] + v[j][1] * v[j][1]) + (v[j][2] * v[j][2] + v[j][3] * v[j][3]);
    const float rstd = 1.0f / sqrtf(wave_sum(s) * (1.0f / DM) + EPS);
    const f32x4* wp = (const f32x4*)w + lane; const f32x4* shp = (const f32x4*)(mod_shift + (size_t)mr * MODW) + lane; const f32x4* scp = (const f32x4*)(mod_scale + (size_t)mr * MODW) + lane;
    u32x2* op = (u32x2*)(H + (size_t)row * DM) + lane;
#pragma unroll
    for (int j = 0; j < 8; ++j) { const f32x4 ww = wp[64 * j], sh = shp[64 * j], sc = scp[64 * j];
        f32x4 y;
#pragma unroll
        for (int e = 0; e < 4; ++e) y[e] = (v[j][e] * rstd * ww[e]) * (1.0f + sc[e]) + sh[e];
        u32x2 o; o.x = pk_bf16(y[0], y[1]); o.y = pk_bf16(y[2], y[3]); op[64 * j] = o; }
}
__device__ __forceinline__ void norm_mod_phase(const float* inL, const float* inC, bf16_t* X, bool from_in, const float* w, const float* mod_shift, const float* mod_scale, bf16_t* H, int nrows, const float* part, const float* pgate, int gw, int NGW, int lane) {
    for (int row = gw; row < nrows; row += 2 * NGW) {
        const int row2 = row + NGW; const bool two = row2 < nrows;
        f32x4 va[8], vb[8];
        norm_row_load(inL, inC, X, from_in, row, lane, va);
        if (two) norm_row_load(inL, inC, X, from_in, row2, lane, vb);
        norm_row_finish(va, X, from_in, w, mod_shift, mod_scale, H, row, part, pgate, lane);
        if (two) norm_row_finish(vb, X, from_in, w, mod_shift, mod_scale, H, row2, part, pgate, lane);
    }
}

#define CAS __attribute__((address_space(4)))
__device__ __forceinline__ const CAS Args* kargs() { const CAS Args* p = (const CAS Args*)__builtin_amdgcn_kernarg_segment_ptr(); asm volatile("" : "+s"(p)); return p; }
__global__ void __launch_bounds__(NTHR, 2) fwd(Args args_unused) {
    extern __shared__ __attribute__((aligned(16))) unsigned char lds_raw[];
    LAS unsigned char* lds = (LAS unsigned char*)lds_raw;
    volatile LAS unsigned* MISC = (volatile LAS unsigned*)(lds + MISC_OFF);
    const int G = gridDim.x, bid = blockIdx.x, NGW = G * NWAVES;
    const int wave_s = __builtin_amdgcn_readfirstlane(threadIdx.x >> 6);
    if (threadIdx.x < 64) MISC[threadIdx.x] = 0u;
    __syncthreads();
    XcdBarrier bar; { const CAS Args* ka0 = kargs(); bar.bar = (unsigned*)(ka0->ws + WS_CTL); bar.x = 0; bar.st = MISC; }
    if (MK_SINGLE) bar = xcd_barrier_post(bar.bar, MISC);
    int lo, hi; { const CAS Args* ka0 = kargs(); lo = ka0->ph_lo; hi = ka0->ph_hi; }
#ifndef PH_MASK
#define PH_MASK 0xffffu
#endif
#define EN(t) (((PH_MASK) >> (t)) & 1u)
#ifndef DUP_MASK
#define DUP_MASK 0u
#endif
#define NREP(t) ((((DUP_MASK) >> (t)) & 1u) ? 2 : 1)
#define IN(k) (lo <= (k) && (k) < hi)
#define SEAM(k) do { if (MK_SINGLE && (k) + 1 < hi) xcd_barrier(bar); } while (0)

#define PH_BEGIN const int wave = wave_s, tid = tid_of(wave), lane = tid & 63, gw = bid * NWAVES + wave; (void)lane; (void)gw; const CAS Args* ka = kargs(); unsigned char* ws = ka->ws; float* MOD = (float*)(ws + WS_MOD); bf16_t* X = (bf16_t*)(ws + WS_X); bf16_t* H = (bf16_t*)(ws + WS_H); \
    const float* ROPE = (const float*)(ws + WS_ROPE); float* LAM = (float*)(ws + WS_LAM); (void)MOD; (void)X; (void)H; (void)ROPE; (void)LAM;
#define PH_BEGIN_L PH_BEGIN const float* modl = MOD + (size_t)l * 9 * MODW; (void)modl;

    if (EN(0) && IN(0)) for (int rep_ = 0; rep_ < NREP(0); ++rep_) { PH_BEGIN
        LAS float* scr = (LAS float*)(lds + wave * 16384);
        for (int j = 0; j < 2; ++j) {
            transpose_matrix(ka->in[IN_DAQKV] + (size_t)j * DM * DA_QKVW, DM, DA_QKVW, (bf16_t*)(ws + WS_WQKV) + (size_t)j * DA_QKVW * DM, 4096, scr, gw, NGW, lane);
            transpose_matrix(ka->in[IN_DAWO] + (size_t)j * DM * DM, DM, DM, (bf16_t*)(ws + WS_WODA) + (size_t)j * DM * DM, 0, scr, gw, NGW, lane);
            transpose_matrix(ka->in[IN_GWIN] + (size_t)j * DM * GDN_INW, DM, GDN_INW, (bf16_t*)(ws + WS_WIN) + (size_t)j * GDN_INW_PAD * DM, 0, scr, gw, NGW, lane);
            transpose_matrix(ka->in[IN_GWO] + (size_t)j * GDN_VW * DM, GDN_VW, DM, (bf16_t*)(ws + WS_WOG) + (size_t)j * DM * GDN_VW, 0, scr, gw, NGW, lane);
        }
        {
            const int l = 0;
            transpose_matrix(ka->in[IN_FUP] + (size_t)l * DM * DFF2, DM, DFF2, (bf16_t*)(ws + WS_WUP) + (size_t)l * DFF2 * DM, -1, scr, gw, NGW, lane);
            transpose_matrix(ka->in[IN_FDN] + (size_t)l * DFF * DM, DFF, DM, (bf16_t*)(ws + WS_WDN) + (size_t)l * DM * DFF, 0, scr, gw, NGW, lane);
        }
        __syncthreads();
        {
            LAS float* sc = (LAS float*)lds;
            LAS float* red = (LAS float*)(lds + 73728);
            if (bid < DEPTH * 48) {
                for (int i = tid; i < 9 * DM; i += NTHR) { const int r = i >> 11, k = i & (DM - 1); const float cv = r < 8 ? ka->in[IN_C][r * DM + k] : ka->in[IN_CCTX][k]; sc[i] = siluf(cv); }
                __syncthreads();
                for (int task = bid; task < DEPTH * 48; task += G) {
                    const int l = task / 48, cb = task % 48;
                    const float* wp = ka->in[IN_WMOD] + ((size_t)l * DM + wave * 256) * MODW + cb * 256 + lane * 4;
                    f32x4 acc[9];
#pragma unroll
                    for (int r = 0; r < 9; ++r) acc[r] = (f32x4){0.f, 0.f, 0.f, 0.f};
                    for (int k = 0; k < 256; k += 4) {
                        const f32x4 w0 = *(const f32x4*)(wp + (size_t)(k + 0) * MODW), w1 = *(const f32x4*)(wp + (size_t)(k + 1) * MODW), w2 = *(const f32x4*)(wp + (size_t)(k + 2) * MODW), w3 = *(const f32x4*)(wp + (size_t)(k + 3) * MODW);
#pragma unroll
                        for (int r = 0; r < 9; ++r) { const f32x4 s4 = *(const LAS f32x4*)(sc + r * DM + wave * 256 + k); acc[r] += s4[0] * w0 + s4[1] * w1 + s4[2] * w2 + s4[3] * w3; }
                    }
#pragma unroll
                    for (int r = 0; r < 9; ++r) *(LAS f32x4*)(red + (wave * 9 + r) * 256 + lane * 4) = acc[r];
                    __syncthreads();
                    for (int o = tid; o < 9 * 256; o += NTHR) { const int r = o >> 8, c = o & 255; float sum = ka->in[IN_BMOD][l * MODW + cb * 256 + c];
#pragma unroll
                        for (int w = 0; w < 8; ++w) sum += red[(w * 9 + r) * 256 + c];
                        MOD[((size_t)l * 9 + r) * MODW + cb * 256 + c] = sum; }
                    __syncthreads();
                }
            }
        }
        if (bid == 0) {
            float* rp = (float*)(ws + WS_ROPE);
            for (int i = tid; i < 64 * 32; i += NTHR) { const int pos = i >> 5, f = i & 31; const float inv = exp2f(-(float)f * (13.287712379549449f / 32.0f)); const float ang = (float)pos * inv;
                rp[2 * i] = __cosf(ang); rp[2 * i + 1] = __sinf(ang); }
        }
        if (bid == 1 && wave < 2) {
            const float* lv = ka->in[IN_DALAM] + wave * 512;
            const float s01 = wave_sum(lv[lane] * lv[128 + lane] + lv[64 + lane] * lv[192 + lane]);
            const float s23 = wave_sum(lv[256 + lane] * lv[384 + lane] + lv[320 + lane] * lv[448 + lane]);
            if (lane == 0) LAM[wave] = __expf(s01) - __expf(s23) + (wave == 0 ? LAMBDA_INIT0 : LAMBDA_INIT2);
        }
        SEAM(0);
    }

    for (int l = 0; l < DEPTH; ++l) {
        const int pb = 1 + 10 * l, j = l >> 1;
        const bool last = (l == DEPTH - 1), gdn = (l & 1);
        const int nrows_out = last ? NLAT : NTOK;

        if (EN(1) && IN(pb + 0)) for (int rep_ = 0; rep_ < NREP(1); ++rep_) { PH_BEGIN_L norm_mod_phase(ka->in[IN_X], ka->in[IN_CTX], X, l == 0, ka->in[IN_NMIX] + l * DM, modl + 0 * DM, modl + 1 * DM, H, NTOK, l > 0 ? (const float*)(ws + WS_PART) : nullptr, MOD + (size_t)(l > 0 ? l - 1 : 0) * 9 * MODW + 5 * DM, gw, NGW, lane); SEAM(pb + 0); }

        if (!gdn) {
            if (EN(2) && IN(pb + 1)) for (int rep_ = 0; rep_ < NREP(2); ++rep_) { PH_BEGIN_L
                pg8::Gemm g{H, (const bf16_t*)(ws + WS_WQKV) + (size_t)j * DA_QKVW * DM, NTOK, DA_QKVW, DM, DM, DM}; pg8::StaticOrder S; S.init(NTOK, DA_QKVW, G, bid);
                pg8::EpiQKV E{(bf16_t*)(ws + WS_QKV), ROPE};
                pg8::gemm_phase<pg8::EpiQKV, pg8::StaticOrder>(lds, g, S, E, wave);
                SEAM(pb + 1);
            }
            if (EN(3) && IN(pb + 3)) for (int rep_ = 0; rep_ < NREP(3); ++rep_) { PH_BEGIN_L
                const bf16_t* QKV = (const bf16_t*)(ws + WS_QKV); bf16_t* O2B = (bf16_t*)(ws + WS_DIFF);
                const float lam = LAM[j];
                const float oml = 1.0f - (j == 0 ? LAMBDA_INIT0 : LAMBDA_INIT2);
                const float* gainp = ka->in[IN_DAGAIN] + j * 256;
                bf16_t* AO = (bf16_t*)(ws + WS_AO);
                const int nunits = 512 + 64;
                const int vid = (G % 8 == 0) ? (bid & 7) * (G >> 3) + (bid >> 3) : bid;
                for (int it = 0;; ++it) {
                    const int u = vid + (it >> 1) * G; if (u >= nunits) break;
                    const int comp = 1 - (it & 1), vh = 0;
                    int b, h, qrow0, n0, seq; const bf16_t *kv0, *kv1;
                    if (u < 512) { b = u >> 6; h = (u >> 3) & 7; const int qb = u & 7; qrow0 = b * SEQ + qb * 256;
                        kv0 = QKV + (size_t)(b * SEQ) * DA_QKVW; n0 = SEQ; kv1 = QKV + (size_t)(NLAT + b * CTXL) * DA_QKVW; seq = SEQ + CTXL; }
                    else { const int v = u - 512; b = v >> 3; h = v & 7; qrow0 = NLAT + b * CTXL;
                        kv0 = QKV + (size_t)(NLAT + b * CTXL) * DA_QKVW; n0 = CTXL; kv1 = kv0; seq = CTXL; }
                    bf16_t* ob = O2B + (size_t)qrow0 * DM + h * 256 + vh * 128; bf16_t* ao = AO + (size_t)qrow0 * DM + h * 256 + vh * 128;
                    const int kcol = 2048 + h * 256 + comp * 128, vcol = 4096 + h * 256 + vh * 128;
                    __syncthreads();
                    att::attn_body256<DA_QKVW, DA_QKVW, DM>(QKV + (size_t)qrow0 * DA_QKVW + h * 256 + comp * 128, kv0 + kcol, kv0 + vcol, n0, kv1 + kcol, kv1 + vcol, seq, ob, comp == 0, lam, ao, gainp, oml, (char*)lds_raw, wave);
                }
                SEAM(pb + 3);
            }
            if (EN(5) && IN(pb + 5)) for (int rep_ = 0; rep_ < NREP(5); ++rep_) { PH_BEGIN_L
                {
                    const bf16_t* Ap = (const bf16_t*)(ws + WS_AO); const bf16_t* Bp = (const bf16_t*)(ws + WS_WODA) + (size_t)j * DM * DM; const int KK = DM;
                    pg8::Gemm g{Ap, Bp, NLAT, DM, KK, KK, KK}; pg8::StaticOrder S; S.init(NLAT, DM, G, bid);
                    pg8::EpiResid E{X, modl + 2 * DM};
                    pg8::gemm_phase<pg8::EpiResid, pg8::StaticOrder>(lds, g, S, E, wave);
                    if (NTOK > NLAT) {
                        for (int sub = bid; sub < 256; sub += G) {
                        const int kq = sub & 3, k128 = KK / 128, kb = (k128 * kq) / 4, ke = (k128 * (kq + 1)) / 4;
                        pg8::Gemm g2{Ap + kb * 128, Bp + kb * 128, NTOK, DM, (ke - kb) * 128, KK, KK}; pg8::TailOrder T{sub};
                        pg8::EpiPartial E2{(float*)(ws + WS_PART) + (size_t)sub * 65536};
                        pg8::gemm_phase<pg8::EpiPartial, pg8::TailOrder>(lds, g2, T, E2, wave); }
                    }
                }
                SEAM(pb + 5);
            }
        } else {
            if (EN(6) && IN(pb + 1)) for (int rep_ = 0; rep_ < NREP(6); ++rep_) { PH_BEGIN_L
                pg8::Gemm g{H, (const bf16_t*)(ws + WS_WIN) + (size_t)j * GDN_INW_PAD * DM, NTOK, GDN_INW_PAD, DM, DM, DM}; pg8::StaticOrder S; S.init(NTOK, GDN_INW_PAD, G, bid);
                pg8::EpiGdnIn E{ws, (bf16_t*)(ws + WS_Z), (float*)(ws + WS_AB), (bf16_t*)(ws + WS_GEDGE), ka->in[IN_GCONV] + (size_t)j * 5 * GDN_QKVW};
                pg8::gemm_phase<pg8::EpiGdnIn, pg8::StaticOrder>(lds, g, S, E, wave);
                SEAM(pb + 1);
            }
            if (EN(7) && IN(pb + 2)) for (int rep_ = 0; rep_ < NREP(7); ++rep_) { PH_BEGIN_L
                const bf16_t* EDGE = (const bf16_t*)(ws + WS_GEDGE); const float* AB = (const float*)(ws + WS_AB);
                bf16_t* QN = (bf16_t*)(ws + WS_QN); bf16_t* KN = (bf16_t*)(ws + WS_KN); bf16_t* VN = (bf16_t*)(ws + WS_VN);
                float* BETA = (float*)(ws + WS_BETA); float* GG = (float*)(ws + WS_G);
                const float* cw = ka->in[IN_GCONV] + (size_t)j * 5 * GDN_QKVW;
                const int ngroups = (NTOK / 64) * 4 * 64;
                for (int gidx = (bid * NTHR + tid) >> 4; gidx < ngroups; gidx += (G * NTHR) >> 4) {
                    const int cg = gidx & 63, r4 = (gidx >> 6) & 3, blk = gidx >> 8;
                    const int r = r4 < 2 ? r4 : 60 + r4, row = blk * 64 + r;
                    const int seqlen = row < NLAT ? SEQ : CTXL; const int t = row < NLAT ? (row & (SEQ - 1)) : ((row - NLAT) & (CTXL - 1));
                    const int ch0 = cg * 128 + (tid & 15) * 8;
                    float y[8];
#pragma unroll
                    for (int e = 0; e < 8; ++e) y[e] = 0.f;
#pragma unroll
                    for (int k = 0; k < 5; ++k) {
                        const int tr = r + k - 2, tt = t + k - 2; const bool ok = (tt >= 0) && (tt < seqlen);
                        const int sb = tr < 0 ? blk - 1 : (tr >= 64 ? blk + 1 : blk), idx = tr < 0 ? 8 + tr : (tr >= 64 ? tr - 64 : (tr < 4 ? tr : tr - 56));
                        const u32x4 q = ok ? *(const u32x4*)(EDGE + ((size_t)sb * 8 + idx) * GDN_QKVW + ch0) : (u32x4){0u, 0u, 0u, 0u};
                        const f32x4 wa = *(const f32x4*)(cw + (size_t)k * GDN_QKVW + ch0), wb = *(const f32x4*)(cw + (size_t)k * GDN_QKVW + ch0 + 4);
                        y[0] += wa[0] * bf_lo(q.x); y[1] += wa[1] * bf_hi(q.x); y[2] += wa[2] * bf_lo(q.y); y[3] += wa[3] * bf_hi(q.y);
                        y[4] += wb[0] * bf_lo(q.z); y[5] += wb[1] * bf_hi(q.z); y[6] += wb[2] * bf_lo(q.w); y[7] += wb[3] * bf_hi(q.w);
                    }
#pragma unroll
                    for (int e = 0; e < 8; ++e) y[e] = siluf(y[e]);
                    bf16_t* dst;
                    if (cg < 32) dst = (cg < 16 ? QN : KN) + (size_t)row * 2048 + (cg & 15) * 128 + (tid & 15) * 8;
                    else dst = VN + (size_t)row * 4096 + (cg - 32) * 128 + (tid & 15) * 8;
                    u32x4 ov; ov.x = pk_bf16(y[0], y[1]); ov.y = pk_bf16(y[2], y[3]); ov.z = pk_bf16(y[4], y[5]); ov.w = pk_bf16(y[6], y[7]);
                    *(u32x4*)dst = ov;
                }
                {
                    const int c = tid & 63, dir = c >> 5, hh = c & 31;
                    const float A = __expf(ka->in[IN_GALOG][j * 64 + c]), dtb = ka->in[IN_GDT][j * 64 + c];
                    for (int i = bid * NTHR + tid; i < NTOK * 64; i += G * NTHR) { const int row = i >> 6;
                        const float* ab = AB + (size_t)row * 128 + dir * 64;
                        const float xb = ab[hh], xd = ab[32 + hh] + dtb;
                        const float sp = fmaxf(xd, 0.f) + log1pf(__expf(-fabsf(xd)));
                        BETA[(size_t)row * 64 + c] = 1.0f / (1.0f + __expf(-xb)); GG[(size_t)row * 64 + c] = -A * sp; }
                }
                SEAM(pb + 2);
            }
            if (EN(8) && IN(pb + 3)) for (int rep_ = 0; rep_ < NREP(8); ++rep_) { PH_BEGIN_L
                const bf16_t* QN = (const bf16_t*)(ws + WS_QN); const bf16_t* KN = (const bf16_t*)(ws + WS_KN); const bf16_t* VN = (const bf16_t*)(ws + WS_VN);
                const float* BETA = (const float*)(ws + WS_BETA); const float* GG = (const float*)(ws + WS_G);
                bf16_t* OF = (bf16_t*)(ws + WS_OF); bf16_t* OB = (bf16_t*)(ws + WS_OB);
#if SCAN_NAIVE
                LAS float* kq = (LAS float*)lds;
                LAS float* part = (LAS float*)(lds + 4096);
                const int cl = tid >> 8, t2 = tid & 255, c = t2 & 127, hf = t2 >> 7;
                for (int ch = bid * 2 + cl; ch < 512 + cl; ch += 2 * G) {
                    const bool live = ch < 512; const int chn = live ? ch : 0;
                    const int dir = chn & 1, hh = (chn >> 1) & 31, b = chn >> 6, qh = hh >> 1;
                    float S[64];
#pragma unroll
                    for (int i = 0; i < 64; ++i) S[i] = 0.f;
                    bf16_t* OUT = dir ? OB : OF;
                    for (int seg = 0; seg < 2; ++seg) {
                        const int L = seg == 0 ? CTXL : SEQ; const int rbase = seg == 0 ? NLAT + b * CTXL : b * SEQ;
                        const bool want = live && (seg == 1 || !last);
                        for (int p = 0; p < L; ++p) {
                            const int row = rbase + (dir ? L - 1 - p : p);
                            if (hf == 0) { kq[cl * 256 + c] = bf2f(KN[(size_t)row * 2048 + qh * 128 + c]); } else { kq[cl * 256 + 128 + c] = bf2f(QN[(size_t)row * 2048 + qh * 128 + c]); }
                            const float vv = bf2f(VN[(size_t)row * 4096 + hh * 128 + c]);
                            const float bt = BETA[(size_t)row * 64 + dir * 32 + hh], a = __expf(GG[(size_t)row * 64 + dir * 32 + hh]);
                            __syncthreads();
                            const LAS float* kp = kq + cl * 256 + hf * 64; const LAS float* qp = kq + cl * 256 + 128 + hf * 64;
                            float r = 0.f;
#pragma unroll
                            for (int i = 0; i < 64; ++i) r += kp[i] * S[i];
                            part[cl * 256 + hf * 128 + c] = r;
                            __syncthreads();
                            const float rt = part[cl * 256 + c] + part[cl * 256 + 128 + c];
                            const float uu = bt * (vv - a * rt);
                            float o = 0.f;
#pragma unroll
                            for (int i = 0; i < 64; ++i) { S[i] = a * S[i] + kp[i] * uu; o += qp[i] * S[i]; }
                            __syncthreads();
                            part[cl * 256 + hf * 128 + c] = o;
                            __syncthreads();
                            if (want && hf == 0) OUT[(size_t)row * 4096 + hh * 128 + c] = (bf16_t)(pk_bf16(part[cl * 256 + c] + part[cl * 256 + 128 + c], 0.f) & 0xffffu);
                        }
                    }
                }
#else
                scan::gdn_scan(QN, KN, VN, BETA, GG, OF, OB, !last, lds, bid, G, wave);
#endif
                SEAM(pb + 3);
            }
            if (EN(9) && IN(pb + 4)) for (int rep_ = 0; rep_ < NREP(9); ++rep_) { PH_BEGIN_L
                const bf16_t* OF = (const bf16_t*)(ws + WS_OF); const bf16_t* OB = (const bf16_t*)(ws + WS_OB); const bf16_t* Z = (const bf16_t*)(ws + WS_Z); bf16_t* Y = (bf16_t*)(ws + WS_Y);
                const float* gp = ka->in[IN_GGAIN] + j * 128 + (tid & 15) * 8;
                const f32x4 g0 = *(const f32x4*)gp, g1 = *(const f32x4*)(gp + 4);
#define G4_ROW(A_, B_, Z_, off) do { \
                        float o[8] = {bf_lo(A_.x) + bf_lo(B_.x), bf_hi(A_.x) + bf_hi(B_.x), bf_lo(A_.y) + bf_lo(B_.y), bf_hi(A_.y) + bf_hi(B_.y), bf_lo(A_.z) + bf_lo(B_.z), bf_hi(A_.z) + bf_hi(B_.z), bf_lo(A_.w) + bf_lo(B_.w), bf_hi(A_.w) + bf_hi(B_.w)}; \
                        const float zz[8] = {bf_lo(Z_.x), bf_hi(Z_.x), bf_lo(Z_.y), bf_hi(Z_.y), bf_lo(Z_.z), bf_hi(Z_.z), bf_lo(Z_.w), bf_hi(Z_.w)}; \
                        float ss = 0.f; \
                        _Pragma("unroll") for (int e = 0; e < 8; ++e) ss += o[e] * o[e]; \
                        ss = sum16(ss); \
                        const float rs = 1.0f / sqrtf(ss * (1.0f / 128.0f) + EPS); \
                        float y[8]; \
                        _Pragma("unroll") for (int e = 0; e < 8; ++e) y[e] = o[e] * rs * (e < 4 ? g0[e] : g1[e - 4]) * siluf(zz[e]); \
                        u32x4 ov; ov.x = pk_bf16(y[0], y[1]); ov.y = pk_bf16(y[2], y[3]); ov.z = pk_bf16(y[4], y[5]); ov.w = pk_bf16(y[6], y[7]); \
                        *(u32x4*)(Y + (off)) = ov; } while (0)
                const int nfull = (nrows_out / (4 * G)) * (4 * G);
                for (int row = bid; row < nfull; row += 4 * G) {
                    const size_t o0 = (size_t)row * 4096 + tid * 8, o1 = o0 + (size_t)G * 4096, o2 = o1 + (size_t)G * 4096, o3 = o2 + (size_t)G * 4096;
                    const u32x4 a0 = *(const u32x4*)(OF + o0), b0 = *(const u32x4*)(OB + o0), z0 = *(const u32x4*)(Z + o0);
                    const u32x4 a1 = *(const u32x4*)(OF + o1), b1 = *(const u32x4*)(OB + o1), z1 = *(const u32x4*)(Z + o1);
                    const u32x4 a2 = *(const u32x4*)(OF + o2), b2_ = *(const u32x4*)(OB + o2), z2 = *(const u32x4*)(Z + o2);
                    const u32x4 a3 = *(const u32x4*)(OF + o3), b3 = *(const u32x4*)(OB + o3), z3 = *(const u32x4*)(Z + o3);
                    G4_ROW(a0, b0, z0, o0); G4_ROW(a1, b1, z1, o1); G4_ROW(a2, b2_, z2, o2); G4_ROW(a3, b3, z3, o3);
                }
                for (int row = nfull + bid; row < nrows_out; row += G) { const size_t o0 = (size_t)row * 4096 + tid * 8;
                    const u32x4 a0 = *(const u32x4*)(OF + o0), b0 = *(const u32x4*)(OB + o0), z0 = *(const u32x4*)(Z + o0); G4_ROW(a0, b0, z0, o0); }
#undef G4_ROW
                SEAM(pb + 4);
            }
            if (EN(10) && IN(pb + 5)) for (int rep_ = 0; rep_ < NREP(10); ++rep_) { PH_BEGIN_L
                {
                    const bf16_t* Ap = (const bf16_t*)(ws + WS_Y); const bf16_t* Bp = (const bf16_t*)(ws + WS_WOG) + (size_t)j * DM * GDN_VW; const int KK = GDN_VW;
                    pg8::Gemm g{Ap, Bp, NLAT, DM, KK, KK, KK}; pg8::StaticOrder S; S.init(NLAT, DM, G, bid);
                    pg8::EpiResid E{X, modl + 2 * DM};
                    pg8::gemm_phase<pg8::EpiResid, pg8::StaticOrder>(lds, g, S, E, wave);
                    if (nrows_out > NLAT) {
                        for (int sub = bid; sub < 256; sub += G) {
                        const int kq = sub & 3, k128 = KK / 128, kb = (k128 * kq) / 4, ke = (k128 * (kq + 1)) / 4;
                        pg8::Gemm g2{Ap + kb * 128, Bp + kb * 128, NTOK, DM, (ke - kb) * 128, KK, KK}; pg8::TailOrder T{sub};
                        pg8::EpiPartial E2{(float*)(ws + WS_PART) + (size_t)sub * 65536};
                        pg8::gemm_phase<pg8::EpiPartial, pg8::TailOrder>(lds, g2, T, E2, wave); }
                    }
                }
                SEAM(pb + 5);
            }
        }

        if (EN(11) && IN(pb + 6)) for (int rep_ = 0; rep_ < NREP(11); ++rep_) { PH_BEGIN_L norm_mod_phase(nullptr, nullptr, X, false, ka->in[IN_NFFN] + l * DM, modl + 3 * DM, modl + 4 * DM, H, nrows_out, (const float*)(ws + WS_PART), modl + 2 * DM, gw, NGW, lane); SEAM(pb + 6); }
        if (EN(12) && IN(pb + 7)) for (int rep_ = 0; rep_ < NREP(12); ++rep_) { PH_BEGIN_L
            pg8::Gemm g{H, (const bf16_t*)(ws + WS_WUP) + (size_t)l * DFF2 * DM, nrows_out, DFF2, DM, DM, DM}; pg8::StaticOrder S; S.init(nrows_out, DFF2, G, bid);
            pg8::EpiUpAct E{(bf16_t*)(ws + WS_ACT), (bf16_t*)(ws + WS_EDGE), ka->in[IN_FCONV] + (size_t)l * 3 * DFF2, lds + 131072};
            pg8::gemm_phase<pg8::EpiUpAct, pg8::StaticOrder>(lds, g, S, E, wave);
            if (l + 1 < DEPTH) {
                const int nwg_u = (nrows_out / 256) * (DFF2 / 256), rem = nwg_u % G;
                if (bid >= rem) { LAS float* scr = (LAS float*)(lds + wave * 16384); const int gwi = (bid - rem) * NWAVES + wave, ngwi = (G - rem) * NWAVES; const int ln = l + 1;
                    transpose_matrix(ka->in[IN_FUP] + (size_t)ln * DM * DFF2, DM, DFF2, (bf16_t*)(ws + WS_WUP) + (size_t)ln * DFF2 * DM, -1, scr, gwi, ngwi, lane);
                    transpose_matrix(ka->in[IN_FDN] + (size_t)ln * DFF * DM, DFF, DM, (bf16_t*)(ws + WS_WDN) + (size_t)ln * DM * DFF, 0, scr, gwi, ngwi, lane); }
            }
            SEAM(pb + 7);
        }
        if (EN(13) && IN(pb + 8)) for (int rep_ = 0; rep_ < NREP(13); ++rep_) { PH_BEGIN_L
            const bf16_t* EDGE = (const bf16_t*)(ws + WS_EDGE); bf16_t* ACT = (bf16_t*)(ws + WS_ACT);
            const float* cw = ka->in[IN_FCONV] + (size_t)l * 3 * DFF2;
            const int nblk = nrows_out / 64, ntasks = nblk * 2 * 688;
            for (int task = bid * NTHR + tid; task < ntasks; task += G * NTHR) {
                const int cg = task % 688, rest = task / 688, which = rest & 1, blk = rest >> 1;
                const int row = blk * 64 + (which ? 63 : 0), ch0 = cg * 8;
                const int seqlen = row < NLAT ? SEQ : CTXL; const int t = row < NLAT ? (row & (SEQ - 1)) : ((row - NLAT) & (CTXL - 1));
                const size_t pos = (size_t)(ch0 >> 7) * 256 + (ch0 & 127);
                const bf16_t* ecur = EDGE + ((size_t)blk * 4 + (which ? 3 : 0)) * DFF2 + pos;
                const bf16_t* eprev = which ? EDGE + ((size_t)blk * 4 + 2) * DFF2 + pos : EDGE + ((size_t)(blk - 1) * 4 + 3) * DFF2 + pos;
                const bf16_t* enext = which ? EDGE + ((size_t)(blk + 1) * 4 + 0) * DFF2 + pos : EDGE + ((size_t)blk * 4 + 1) * DFF2 + pos;
                const bool okp = t > 0, okn = t + 1 < seqlen;
                const u32x4 z4 = {0u, 0u, 0u, 0u};
                const u32x4 gc = *(const u32x4*)ecur, vc = *(const u32x4*)(ecur + 128);
                const u32x4 gp = okp ? *(const u32x4*)eprev : z4, vp = okp ? *(const u32x4*)(eprev + 128) : z4;
                const u32x4 gn = okn ? *(const u32x4*)enext : z4, vn = okn ? *(const u32x4*)(enext + 128) : z4;
                float wg[3][8], wv[3][8];
#pragma unroll
                for (int k = 0; k < 3; ++k) { const f32x4 a = *(const f32x4*)(cw + (size_t)k * DFF2 + ch0), b2 = *(const f32x4*)(cw + (size_t)k * DFF2 + ch0 + 4);
                    const f32x4 c2 = *(const f32x4*)(cw + (size_t)k * DFF2 + DFF + ch0), d2 = *(const f32x4*)(cw + (size_t)k * DFF2 + DFF + ch0 + 4);
#pragma unroll
                    for (int e = 0; e < 4; ++e) { wg[k][e] = a[e]; wg[k][4 + e] = b2[e]; wv[k][e] = c2[e]; wv[k][4 + e] = d2[e]; } }
#define UNPK8(q, f) do { f[0] = bf_lo(q.x); f[1] = bf_hi(q.x); f[2] = bf_lo(q.y); f[3] = bf_hi(q.y); f[4] = bf_lo(q.z); f[5] = bf_hi(q.z); f[6] = bf_lo(q.w); f[7] = bf_hi(q.w); } while (0)
                float fgp[8], fgc[8], fgn[8], fvp[8], fvc[8], fvn[8];
                UNPK8(gp, fgp); UNPK8(gc, fgc); UNPK8(gn, fgn); UNPK8(vp, fvp); UNPK8(vc, fvc); UNPK8(vn, fvn);
#undef UNPK8
                float y[8];
#pragma unroll
                for (int e = 0; e < 8; ++e) { const float yg = wg[0][e] * fgp[e] + wg[1][e] * fgc[e] + wg[2][e] * fgn[e], yv = wv[0][e] * fvp[e] + wv[1][e] * fvc[e] + wv[2][e] * fvn[e]; y[e] = siluf(yg) * yv; }
                u32x4 ov; ov.x = pk_bf16(y[0], y[1]); ov.y = pk_bf16(y[2], y[3]); ov.z = pk_bf16(y[4], y[5]); ov.w = pk_bf16(y[6], y[7]);
                *(u32x4*)(ACT + (size_t)row * DFF + ch0) = ov;
            }
            SEAM(pb + 8);
        }
        if (EN(14) && IN(pb + 9)) for (int rep_ = 0; rep_ < NREP(14); ++rep_) { PH_BEGIN_L
            {
                    const bf16_t* Ap = (const bf16_t*)(ws + WS_ACT); const bf16_t* Bp = (const bf16_t*)(ws + WS_WDN) + (size_t)l * DM * DFF; const int KK = DFF;
                    pg8::Gemm g{Ap, Bp, NLAT, DM, KK, KK, KK}; pg8::StaticOrder S; S.init(NLAT, DM, G, bid);
                    pg8::EpiResid E{X, modl + 5 * DM};
                    pg8::gemm_phase<pg8::EpiResid, pg8::StaticOrder>(lds, g, S, E, wave);
                    if (nrows_out > NLAT) {
                        for (int sub = bid; sub < 256; sub += G) {
                        const int kq = sub & 3, k128 = KK / 128, kb = (k128 * kq) / 4, ke = (k128 * (kq + 1)) / 4;
                        pg8::Gemm g2{Ap + kb * 128, Bp + kb * 128, NTOK, DM, (ke - kb) * 128, KK, KK}; pg8::TailOrder T{sub};
                        pg8::EpiPartial E2{(float*)(ws + WS_PART) + (size_t)sub * 65536};
                        pg8::gemm_phase<pg8::EpiPartial, pg8::TailOrder>(lds, g2, T, E2, wave); }
                    }
                }
            SEAM(pb + 9);
        }
    }

    if (EN(15) && IN(1 + 10 * DEPTH)) for (int rep_ = 0; rep_ < NREP(15); ++rep_) { PH_BEGIN
        const float* w = ka->in[IN_FNORM];
        for (int row = gw; row < NLAT; row += NGW) {
            const u32x2* xr = (const u32x2*)(X + (size_t)row * DM) + lane; f32x4* op = (f32x4*)(ka->out + (size_t)row * DM) + lane;
            f32x4 v[8]; float s = 0.f;
#pragma unroll
            for (int jj = 0; jj < 8; ++jj) { const u32x2 q = xr[64 * jj]; v[jj] = (f32x4){xs_lo(q.x), xs_hi(q.x), xs_lo(q.y), xs_hi(q.y)}; s += (v[jj][0] * v[jj][0] + v[jj][1] * v[jj][1]) + (v[jj][2] * v[jj][2] + v[jj][3] * v[jj][3]); }
            const float rstd = 1.0f / sqrtf(wave_sum(s) * (1.0f / DM) + EPS);
#pragma unroll
            for (int jj = 0; jj < 8; ++jj) { const f32x4 ww = *((const f32x4*)w + lane + 64 * jj); op[64 * jj] = v[jj] * rstd * ww; }
        }
    }
#undef IN
#undef SEAM
}

constexpr int NPHASES = 2 + 10 * DEPTH;
extern "C" void kernel_launch(void* const* d_in, const int* in_sizes, int n_in, void* d_out, int out_size, void* d_ws, size_t ws_size, hipStream_t stream) {
    static int grid = 0;
    if (grid == 0) {
        if (n_in != 22 || out_size != NLAT * DM || ws_size < WS_END) { fprintf(stderr, "kernel_launch: unexpected shapes: n_in %d out %d ws %zu (need %zu)\n", n_in, out_size, ws_size, (size_t)WS_END); grid = -1; return; }
        int dev = 0, cus = 0, per_cu = 0;
        if (hipGetDevice(&dev) != hipSuccess || hipDeviceGetAttribute(&cus, hipDeviceAttributeMultiprocessorCount, dev) != hipSuccess) { grid = -1; return; }
        if (hipFuncSetAttribute((const void*)fwd, hipFuncAttributeMaxDynamicSharedMemorySize, LDS_BYTES) != hipSuccess) { fprintf(stderr, "kernel_launch: hipFuncSetAttribute failed\n"); grid = -1; return; }
        if (hipOccupancyMaxActiveBlocksPerMultiprocessor(&per_cu, (const void*)fwd, NTHR, LDS_BYTES) != hipSuccess || per_cu < 1) fprintf(stderr, "kernel_launch: occupancy query reports %d\n", per_cu);
        (void)hipGetLastError();
        grid = cus;
    }
    if (grid < 0) return;
    if (hipMemsetAsync((char*)d_ws + WS_CTL, 0, CTL_ZERO_BYTES, stream) != hipSuccess) return;
    Args a{};
    for (int i = 0; i < 22; ++i) a.in[i] = (const float*)d_in[i];
    a.out = (float*)d_out; a.ws = (unsigned char*)d_ws;
#if MK_SINGLE
    a.ph_lo = 0; a.ph_hi = NPHASES; a.li = 0;
    hipLaunchKernelGGL(fwd, dim3(grid), dim3(NTHR), LDS_BYTES, stream, a);
#else
    for (int p = 0; p < NPHASES; ++p) {
        if (p >= 1 && p < 1 + 10 * DEPTH) { const int l = (p - 1) / 10, k = (p - 1) % 10; if (k == 2 && !(l & 1)) continue; }
        a.ph_lo = p; a.ph_hi = p + 1; a.li = 0;
        hipLaunchKernelGGL(fwd, dim3(grid), dim3(NTHR), LDS_BYTES, stream, a);
    }
#endif
    const hipError_t le = hipPeekAtLastError();
    if (le != hipSuccess) fprintf(stderr, "kernel_launch: launch failed: %s\n", hipGetErrorName(le));
}
```

```cpp
#include <hip/hip_runtime.h>
#include <cstdio>
#include <cstdint>

#ifndef MK_SINGLE
#define MK_SINGLE 1
#endif
#ifndef ATTN_SINGLE
#define ATTN_SINGLE 1
#endif
#ifndef SCAN_NAIVE
#define SCAN_NAIVE 0
#endif

#define LAS __attribute__((address_space(3)))
#define GAS __attribute__((address_space(1)))
typedef unsigned short bf16_t;
typedef short bf16x8 __attribute__((ext_vector_type(8)));
typedef short s16x4 __attribute__((ext_vector_type(4)));
typedef float f32x2 __attribute__((ext_vector_type(2)));
typedef float f32x4 __attribute__((ext_vector_type(4)));
typedef float f32x8 __attribute__((ext_vector_type(8)));
typedef float f32x16 __attribute__((ext_vector_type(16)));
typedef unsigned u32x2 __attribute__((ext_vector_type(2)));
typedef unsigned u32x4 __attribute__((ext_vector_type(4)));
typedef __bf16 bf2_t __attribute__((ext_vector_type(2)));

constexpr int DM = 2048, BATCH = 8, SEQ = 2048, CTXL = 256, DEPTH = 4;
constexpr int NLAT = BATCH * SEQ;
constexpr int NCTX = BATCH * CTXL;
constexpr int NTOK = NLAT + NCTX;
constexpr int DA_H = 8, DA_QKVW = 6144;
constexpr int GDN_QKH = 16, GDN_VH = 32, GDN_QKVW = 8192, GDN_VW = 4096, GDN_INW = 12416, GDN_INW_PAD = 12544;
constexpr int DFF = 5504, DFF2 = 11008;
constexpr int MODW = 6 * DM;
constexpr float EPS = 1e-6f;
constexpr float LAMBDA_INIT0 = 0.2f;
constexpr float LAMBDA_INIT2 = 0.47071301834358414f;

constexpr size_t MiB = 1u << 20;
constexpr size_t WS_CTL = 0, CTL_ZERO_BYTES = 4 * MiB;
constexpr size_t WS_MOD = 1 * MiB;
constexpr size_t WS_ROPE = 3 * MiB;
constexpr size_t WS_LAM = 3 * MiB + 64 * 1024;
constexpr size_t WS_WQKV = 4 * MiB;
constexpr size_t WS_WODA = WS_WQKV + 48 * MiB;
constexpr size_t WS_WIN = WS_WODA + 16 * MiB;
constexpr size_t WS_WOG = WS_WIN + 98 * MiB;
constexpr size_t WS_WUP = WS_WOG + 32 * MiB;
constexpr size_t WS_WDN = WS_WUP + 172 * MiB;
constexpr size_t WS_X = WS_WDN + 86 * MiB;
constexpr size_t WS_H = WS_X + 144 * MiB;
constexpr size_t WS_R = WS_H + 72 * MiB;
constexpr size_t WS_QKV = WS_R;
constexpr size_t WS_DIFF = WS_QKV + 216 * MiB;
constexpr size_t WS_AO = WS_DIFF + 144 * MiB;
constexpr size_t WS_RAW = WS_R;
constexpr size_t WS_OF = WS_R, WS_OB = WS_R + 144 * MiB;
constexpr size_t WS_GEDGE = WS_R;
constexpr size_t WS_Z = WS_RAW + 288 * MiB;
constexpr size_t WS_AB = WS_Z + 144 * MiB;
constexpr size_t WS_QN = WS_AB + 9 * MiB;
constexpr size_t WS_KN = WS_QN + 72 * MiB;
constexpr size_t WS_Y = WS_QN;
constexpr size_t WS_VN = WS_KN + 72 * MiB;
constexpr size_t WS_BETA = WS_VN + 144 * MiB;
constexpr size_t WS_G = WS_BETA + (9 * MiB) / 2;
constexpr size_t WS_EDGE = WS_R;
constexpr size_t WS_U = WS_R;
constexpr size_t WS_ACT = WS_U + 387 * MiB;
constexpr size_t WS_PART = WS_R + 738 * MiB;
constexpr size_t WS_END = WS_PART + 64 * MiB;
static_assert(WS_G + (9 * MiB) / 2 <= WS_END && WS_ACT + 194 * MiB <= WS_END && WS_AO + 72 * MiB <= WS_END, "ws map");
static_assert(WS_END <= (size_t)1536 * MiB, "ws map exceeds 4x the largest input");

constexpr int LDS_BYTES = 160 * 1024;
constexpr int MISC_OFF = LDS_BYTES - 256;

__device__ __forceinline__ unsigned pk_bf16(float lo, float hi) { f32x2 v = {lo, hi}; return __builtin_bit_cast(unsigned, __builtin_convertvector(v, bf2_t)); }
__device__ __forceinline__ float bf_lo(unsigned w) { return __uint_as_float(w << 16); }
__device__ __forceinline__ float bf_hi(unsigned w) { return __uint_as_float(w & 0xffff0000u); }
typedef _Float16 f16x2_t __attribute__((ext_vector_type(2)));
__device__ __forceinline__ float xs_lo(unsigned w) { return (float)__builtin_bit_cast(f16x2_t, w)[0]; }
__device__ __forceinline__ float xs_hi(unsigned w) { return (float)__builtin_bit_cast(f16x2_t, w)[1]; }
__device__ __forceinline__ unsigned pk_xs(float a, float b) { f16x2_t v; v[0] = (_Float16)a; v[1] = (_Float16)b; return __builtin_bit_cast(unsigned, v); }
__device__ __forceinline__ float bf2f(bf16_t b) { return __uint_as_float(((unsigned)b) << 16); }
template <int CTRL> __device__ __forceinline__ float dpp_f(float v) { return __builtin_bit_cast(float, __builtin_amdgcn_update_dpp(0, __builtin_bit_cast(int, v), CTRL, 0xF, 0xF, true)); }
__device__ __forceinline__ float sum16(float v) { v += dpp_f<0xB1>(v); v += dpp_f<0x4E>(v); v += dpp_f<0x141>(v); v += dpp_f<0x140>(v); return v; }
__device__ __forceinline__ float lane_bcast(float v, int l) { return __builtin_bit_cast(float, __builtin_amdgcn_readlane(__builtin_bit_cast(int, v), l)); }
__device__ __forceinline__ float wave_sum(float v) {
    v = sum16(v);
    return (lane_bcast(v, 0) + lane_bcast(v, 16)) + (lane_bcast(v, 32) + lane_bcast(v, 48));
}
__device__ __forceinline__ int tid_of(int wv) { int t = (wv << 6) | (int)__builtin_amdgcn_mbcnt_hi(~0u, __builtin_amdgcn_mbcnt_lo(~0u, 0u)); asm volatile("" : "+v"(t)); return t; }
__device__ __forceinline__ float siluf(float x) { return x * __builtin_amdgcn_rcpf(1.0f + __expf(-x)); }

#define XB_TMO      128
#define XB_XCNT(j)  (256  + 64 * (j))
#define XB_XSUB(j)  (1280 + 64 * (j))
#define XB_XGEN(j)  (2304 + 64 * (j))
#define XB_TOP      3328
#define XB_TOPGEN   3392
#define XCD_BAR_WORDS 3456
#define XB_SPIN_CAP (1u << 20)
__device__ __forceinline__ unsigned xb_ld(unsigned* p)              { return __hip_atomic_load(p, __ATOMIC_RELAXED, __HIP_MEMORY_SCOPE_AGENT); }
__device__ __forceinline__ unsigned xb_add(unsigned* p, unsigned v) { return __hip_atomic_fetch_add(p, v, __ATOMIC_RELAXED, __HIP_MEMORY_SCOPE_AGENT); }
__device__ __forceinline__ unsigned xb_xcc_id() { return (unsigned)__builtin_amdgcn_s_getreg((3 << 11) | 20) & 0xFu; }
#define XB_SPIN(cond, bar) do { unsigned _sp = 0; while (cond) { __builtin_amdgcn_s_sleep(1); \
    if ((++_sp & 255u) == 0u) { if (xb_ld(&(bar)[XB_TMO])) break; if (_sp > XB_SPIN_CAP) { atomicAdd(&(bar)[XB_TMO], 1u); break; } } } } while (0)
struct XcdBarrier { unsigned* bar; unsigned x; volatile LAS unsigned* st; };
__device__ __forceinline__ XcdBarrier xcd_barrier_post(unsigned* bar, volatile LAS unsigned* st) {
    XcdBarrier b; b.bar = bar; b.x = xb_xcc_id(); b.st = st;
    if (threadIdx.x == 0) (void)xb_add(&bar[XB_XCNT(b.x)], 1u);
    return b;
}
__device__ __forceinline__ void xcd_barrier_complete(unsigned* bar, unsigned x, unsigned& nloc, unsigned& nx) {
    const unsigned G = gridDim.x * gridDim.y * gridDim.z;
    unsigned sum, cnt, mine, sp = 0u;
    for (;;) {
        sum = 0u; cnt = 0u; mine = 0u;
#pragma unroll
        for (unsigned j = 0; j < 16; ++j) { const unsigned c = xb_ld(&bar[XB_XCNT(j)]); sum += c; cnt += (c > 0u) ? 1u : 0u; mine = (j == x) ? c : mine; }
        if (sum == G) break;
        __builtin_amdgcn_s_sleep(1);
        if ((++sp & 255u) == 0u) { if (xb_ld(&bar[XB_TMO])) break; if (sp > XB_SPIN_CAP) { atomicAdd(&bar[XB_TMO], 1u); break; } }
    }
    nloc = mine > 0u ? mine : 1u; nx = cnt > 0u ? cnt : 1u;
}
__device__ __forceinline__ void xcd_barrier(const XcdBarrier& b) {
    asm volatile("s_waitcnt vmcnt(0)" ::: "memory");
    __syncthreads();
    if (threadIdx.x == 0) {
        unsigned* bar = b.bar;
        __builtin_amdgcn_s_waitcnt(0);
        unsigned nloc = b.st[0], nx = b.st[1];
        if (nloc == 0u) { xcd_barrier_complete(bar, b.x, nloc, nx); b.st[0] = nloc; b.st[1] = nx; }
        const unsigned old = xb_add(&bar[XB_XSUB(b.x)], 1u);
        const unsigned gen = old / nloc;
        if (old + 1u == (gen + 1u) * nloc) {
            __builtin_amdgcn_fence(__ATOMIC_RELEASE, "agent");
            asm volatile("s_waitcnt vmcnt(0)" ::: "memory");
            const unsigned og = xb_add(&bar[XB_TOP], 1u);
            const unsigned tg = og / nx;
            if (og + 1u == (tg + 1u) * nx) xb_add(&bar[XB_TOPGEN], 1u);
            else XB_SPIN(xb_ld(&bar[XB_TOPGEN]) == tg, bar);
            __builtin_amdgcn_fence(__ATOMIC_ACQUIRE, "agent");
            xb_add(&bar[XB_XGEN(b.x)], 1u);
            asm volatile("s_waitcnt vmcnt(0)" ::: "memory");
        } else {
            XB_SPIN(xb_ld(&bar[XB_XGEN(b.x)]) == gen, bar);
            __builtin_amdgcn_fence(__ATOMIC_ACQUIRE, "agent");
            asm volatile("s_waitcnt vmcnt(0)" ::: "memory");
        }
    }
    __syncthreads();
}

namespace pg8 {
constexpr int BM = 256, BK = 64, HALF = 128, HTB = HALF * BK * 2, STAGE_BYTES = 8 * HTB, NXCD = 8, WGM = 8;
__host__ __device__ __forceinline__ int lds_byte(int r, int c) { const int st = (r >> 4) * 2 + (c >> 5), rr = r & 15, cc = c & 31, ob = rr * 64 + cc * 2; return st * 1024 + (ob ^ (((ob >> 9) & 1) << 5)); }
__host__ __device__ __forceinline__ void stage_rc(int b, int& R, int& C) { const int st = b / 1024, sb = b % 1024, swz = sb ^ (((sb >> 9) & 1) << 5); R = (st >> 1) * 16 + swz / 64; C = (st & 1) * 32 + (swz % 64) / 2; }
__host__ __device__ __forceinline__ int perm32(int rho) { const int n = rho >> 4, i = rho & 15; return 8 * (i >> 2) + 4 * n + (i & 3); }
struct Unit { int pm, pn; };
struct Gemm { const bf16_t* A; const bf16_t* Bt; int M, N, K, lda, ldb; };
struct StaticOrder {
    int nM, nN, nwg, G, c;
    __device__ void init(int M, int N, int G_, int c_) { nM = M / BM; nN = N / BM; nwg = nM * nN; G = G_; c = c_; }
    __device__ bool next(int i, Unit& u) const {
        const long L = (long)i * G + c; if (L >= nwg) return false;
        int wgid = (int)L; { const int q = nwg / NXCD, r = nwg % NXCD, xcd = wgid % NXCD, off = wgid / NXCD; wgid = (xcd < r ? xcd * (q + 1) : r * (q + 1) + (xcd - r) * q) + off; }
        const int nig = WGM * nN, gid = wgid / nig, fm = gid * WGM, gsz = (nM - fm) < WGM ? (nM - fm) : WGM;
        u.pm = fm + ((wgid % nig) % gsz); u.pn = (wgid % nig) / gsz; return true;
    }
};
struct TailOrder {
    int c;
    __device__ bool next(int i, Unit& u) const { if (i > 0 || c >= 256) return false; const int tix = c >> 2; u.pm = 64 + (tix >> 3); u.pn = tix & 7; return true; }
};
template <class Epi, class Order>
__device__ __forceinline__ void gemm_phase(LAS unsigned char* lds, const Gemm g, const Order& S, const Epi& E, int wv) {
    const int tid = tid_of(wv), wid = wv, lane = tid & 63, wr = wid >> 2, wc = wid & 3, fr = lane & 15, fq = lane >> 4;
    const int K = g.K, nt = K / BK;
    unsigned voffA[2], voffB[2];
#pragma unroll
    for (int i = 0; i < 2; ++i) { int R, C; stage_rc(tid * 16 + i * 8192, R, C); const int Rb = Epi::PERM ? ((R & ~31) + perm32(R & 31)) : R;
        voffA[i] = (unsigned)(R * g.lda + C) * 2u; voffB[i] = (unsigned)(Rb * g.ldb + C) * 2u; }
    const size_t kstep = (size_t)(BK * 2);
    const size_t hstepA = (size_t)HALF * g.lda * 2, hstepB = (size_t)HALF * g.ldb * 2;
    const size_t tstepA = 2 * hstepA, tstepB = 2 * hstepB;
    const unsigned ldsw = (unsigned)wid * 1024u;
    const int aoff = lds_byte(wr * 64 + fr, fq * 8), boff = lds_byte(wc * 32 + fr, fq * 8);
#define PG8_SA(b, h) (((b) * 2 + (h)) * HTB)
#define PG8_SB(b, h) ((4 + (b) * 2 + (h)) * HTB)
#define PG8_STAGE(bufoff, gbase, voff) do { _Pragma("unroll") for (int _i = 0; _i < 2; ++_i) \
        __builtin_amdgcn_global_load_lds((const unsigned*)((const char*)(gbase) + (voff)[_i]), (LAS unsigned*)(lds + (bufoff) + ldsw + _i * 8192), 16, 0, 0); } while (0)
#define PG8_LDA(dst, b, h) do { _Pragma("unroll") for (int m = 0; m < 4; ++m) _Pragma("unroll") for (int k = 0; k < 2; ++k) dst[m][k] = *(const LAS bf16x8*)(lds + PG8_SA(b, h) + aoff + m * 2048 + k * 1024); } while (0)
#define PG8_LDB(dst, b, h) do { _Pragma("unroll") for (int n = 0; n < 2; ++n) _Pragma("unroll") for (int k = 0; k < 2; ++k) dst[n][k] = *(const LAS bf16x8*)(lds + PG8_SB(b, h) + boff + n * 2048 + k * 1024); } while (0)
#define PG8_MMA(ai, bj, At, Bt) do { __builtin_amdgcn_s_setprio(1); _Pragma("unroll") for (int m = 0; m < 4; ++m) _Pragma("unroll") for (int n = 0; n < 2; ++n) _Pragma("unroll") for (int k = 0; k < 2; ++k) \
        acc[ai][bj][m][n] = __builtin_amdgcn_mfma_f32_16x16x32_bf16(Bt[n][k], At[m][k], acc[ai][bj][m][n], 0, 0, 0); __builtin_amdgcn_s_setprio(0); } while (0)
#define PG8_WAIT_V(n) asm volatile("s_waitcnt vmcnt(" #n ")" ::: "memory")
#define PG8_WAIT_L(n) asm volatile("s_waitcnt lgkmcnt(" #n ")" ::: "memory")
#define PG8_BAR __builtin_amdgcn_s_barrier()
#define PG8_SCHED __builtin_amdgcn_sched_barrier(0)
    Unit cur, nxt; int ui = 0;
    if (!S.next(0, cur)) return;
    f32x4 acc[2][2][4][2];
#pragma unroll
    for (int a = 0; a < 2; ++a)
#pragma unroll
        for (int b = 0; b < 2; ++b)
#pragma unroll
            for (int m = 0; m < 4; ++m)
#pragma unroll
                for (int n = 0; n < 2; ++n) acc[a][b][m][n] = (f32x4){0.f, 0.f, 0.f, 0.f};
    bf16x8 At[4][2], B0[2][2], B1[2][2];
    const char* cA = (const char*)g.A + (size_t)cur.pm * tstepA; const char* cB = (const char*)g.Bt + (size_t)cur.pn * tstepB;
    int wbuf = 0;
    if constexpr (Epi::LDSW) E.stage_w(cur, 0, wv);
    PG8_STAGE(PG8_SB(0, 0), cB, voffB); PG8_STAGE(PG8_SB(0, 1), cB + hstepB, voffB); PG8_STAGE(PG8_SA(0, 0), cA, voffA); PG8_STAGE(PG8_SA(0, 1), cA + hstepA, voffA);
    if (wr == 1) PG8_BAR;
    PG8_WAIT_V(2); PG8_BAR;
    PG8_STAGE(PG8_SB(1, 0), cB + kstep, voffB); PG8_STAGE(PG8_SA(1, 0), cA + kstep, voffA); PG8_STAGE(PG8_SB(1, 1), cB + hstepB + kstep, voffB);
    PG8_WAIT_V(6); PG8_BAR;
#define PG8_WAIT_VN(n) asm volatile("s_waitcnt vmcnt(%0)" :: "n"(n) : "memory")
#define PG8_TRIP(ST11, W1, W2, W3, W4) do { \
            const bool last = (t == nt - 2); \
            const char* a1 = cA + (size_t)(t + 1) * kstep; \
            const char* a2 = last ? nA : cA + (size_t)(t + 2) * kstep; const char* b2 = last ? nB : cB + (size_t)(t + 2) * kstep; \
            const char* a3 = a2 + kstep; const char* b3 = b2 + kstep; \
            PG8_LDB(B0, 0, 0); PG8_LDB(B1, 0, 1); PG8_SCHED; PG8_LDA(At, 0, 0); if (ST11) PG8_STAGE(PG8_SA(1, 1), a1 + hstepA, voffA); \
            PG8_WAIT_VN(W1); PG8_WAIT_L(0); PG8_BAR; PG8_MMA(0, 0, At, B0); PG8_MMA(0, 1, At, B1); PG8_BAR; PG8_SCHED; \
            PG8_LDA(At, 0, 1); PG8_STAGE(PG8_SB(0, 0), b2, voffB); PG8_STAGE(PG8_SB(0, 1), b2 + hstepB, voffB); PG8_STAGE(PG8_SA(0, 0), a2, voffA); \
            PG8_WAIT_VN(W2); PG8_WAIT_L(0); PG8_BAR; PG8_MMA(1, 0, At, B0); PG8_MMA(1, 1, At, B1); PG8_BAR; PG8_SCHED; \
            PG8_LDB(B0, 1, 0); PG8_LDB(B1, 1, 1); PG8_SCHED; PG8_LDA(At, 1, 0); PG8_STAGE(PG8_SA(0, 1), a2 + hstepA, voffA); \
            PG8_WAIT_VN(W3); PG8_WAIT_L(0); PG8_BAR; PG8_MMA(0, 0, At, B0); PG8_MMA(0, 1, At, B1); PG8_BAR; PG8_SCHED; \
            PG8_LDA(At, 1, 1); PG8_STAGE(PG8_SB(1, 0), b3, voffB); PG8_STAGE(PG8_SB(1, 1), b3 + hstepB, voffB); PG8_STAGE(PG8_SA(1, 0), a3, voffA); \
            PG8_WAIT_VN(W4); PG8_WAIT_L(0); PG8_BAR; PG8_MMA(1, 0, At, B0); PG8_MMA(1, 1, At, B1); PG8_BAR; PG8_SCHED; } while (0)
    constexpr int EV = Epi::VMOPS > 40 ? 40 : Epi::VMOPS;
    bool pre = false;
    for (;;) {
        const bool has_next = S.next(ui + 1, nxt);
        const char* nA = has_next ? (const char*)g.A + (size_t)nxt.pm * tstepA : cA; const char* nB = has_next ? (const char*)g.Bt + (size_t)nxt.pn * tstepB : cB;
        int t = 0;
        if (pre) { PG8_TRIP(false, 8 + EV, 8 + EV, 8 + EV, 8); t = 2; }
        for (; t < nt; t += 2) PG8_TRIP(true, 8, 8, 8, 8);
        if (Epi::PRESTAGE && has_next) { PG8_STAGE(PG8_SA(1, 1), nA + kstep + hstepA, voffA); pre = true; }
        if constexpr (Epi::LDSW) { if (has_next) E.stage_w(nxt, wbuf ^ 1, wv); }
        if (wr == 0) PG8_BAR;
        PG8_SCHED;
        { const int l2 = tid_of(wv) & 63; if constexpr (Epi::LDSW) E.run(acc, cur, wr, wc, l2 & 15, l2 >> 4, wbuf); else E(acc, cur, wr, wc, l2 & 15, l2 >> 4); }
        PG8_SCHED;
        if (!has_next) break;
#pragma unroll
        for (int a = 0; a < 2; ++a)
#pragma unroll
            for (int b = 0; b < 2; ++b)
#pragma unroll
                for (int m = 0; m < 4; ++m)
#pragma unroll
                    for (int n = 0; n < 2; ++n) { acc[a][b][m][n] = (f32x4){0.f, 0.f, 0.f, 0.f}; asm volatile("" : "+v"(acc[a][b][m][n])); }
        cur = nxt; cA = nA; cB = nB; ++ui; wbuf ^= 1;
        if (wr == 1) PG8_BAR;
    }
#undef PG8_TRIP
#undef PG8_WAIT_VN
    PG8_WAIT_V(0);
    PG8_BAR;
#undef PG8_SA
#undef PG8_SB
#undef PG8_STAGE
#undef PG8_LDA
#undef PG8_LDB
#undef PG8_MMA
#undef PG8_WAIT_V
#undef PG8_WAIT_L
#undef PG8_BAR
#undef PG8_SCHED
}

__device__ __forceinline__ int mod_row_of_tile(int pm) { return pm < 64 ? (pm >> 3) : 8; }

struct EpiResid {
    static constexpr bool LDSW = false; static constexpr bool PRESTAGE = true; static constexpr bool PERM = true; static constexpr int VMOPS = 16;
    bf16_t* X; const float* gate;
    __device__ __forceinline__ void operator()(const f32x4 (&acc)[2][2][4][2], const Unit& u, int wr, int wc, int fr, int fq) const {
        const int row0 = u.pm * BM + wr * 64 + fr, col0 = u.pn * BM + wc * 32 + 8 * fq;
        const float* gp = gate + (size_t)mod_row_of_tile(u.pm) * MODW + col0;
        f32x4 gv[2][2];
#pragma unroll
        for (int bj = 0; bj < 2; ++bj)
#pragma unroll
            for (int n = 0; n < 2; ++n) gv[bj][n] = *(const f32x4*)(gp + bj * HALF + 4 * n);
#pragma unroll
        for (int ai = 0; ai < 2; ++ai) {
            u32x4 xb[4][2];
#pragma unroll
            for (int m = 0; m < 4; ++m) { const bf16_t* srcp = X + (size_t)(row0 + ai * HALF + m * 16) * DM + col0;
#pragma unroll
                for (int bj = 0; bj < 2; ++bj) xb[m][bj] = *(const u32x4*)(srcp + bj * HALF); }
            asm volatile("" ::: "memory");
#pragma unroll
            for (int m = 0; m < 4; ++m) { bf16_t* rowp = X + (size_t)(row0 + ai * HALF + m * 16) * DM + col0;
#pragma unroll
                for (int bj = 0; bj < 2; ++bj) { const u32x4 q = xb[m][bj]; const f32x4 a0 = acc[ai][bj][m][0], a1 = acc[ai][bj][m][1], g0 = gv[bj][0], g1 = gv[bj][1];
                    u32x4 w;
                    w.x = pk_xs(xs_lo(q.x) + g0[0] * a0[0], xs_hi(q.x) + g0[1] * a0[1]); w.y = pk_xs(xs_lo(q.y) + g0[2] * a0[2], xs_hi(q.y) + g0[3] * a0[3]);
                    w.z = pk_xs(xs_lo(q.z) + g1[0] * a1[0], xs_hi(q.z) + g1[1] * a1[1]); w.w = pk_xs(xs_lo(q.w) + g1[2] * a1[2], xs_hi(q.w) + g1[3] * a1[3]);
                    *(u32x4*)(rowp + bj * HALF) = w; } }
            asm volatile("" ::: "memory");
        }
    }
};
struct EpiPartial {
    static constexpr bool LDSW = false; static constexpr bool PRESTAGE = true; static constexpr bool PERM = false; static constexpr int VMOPS = 32;
    float* P;
    __device__ __forceinline__ void operator()(const f32x4 (&acc)[2][2][4][2], const Unit& u, int wr, int wc, int fr, int fq) const {
        const int row0 = wr * 64 + fr, col0 = wc * 32 + 4 * fq;
#pragma unroll
        for (int ai = 0; ai < 2; ++ai)
#pragma unroll
            for (int m = 0; m < 4; ++m) { float* rowp = P + (size_t)(row0 + ai * HALF + m * 16) * 256 + col0;
#pragma unroll
                for (int bj = 0; bj < 2; ++bj)
#pragma unroll
                    for (int n = 0; n < 2; ++n) *(f32x4*)(rowp + bj * HALF + n * 16) = acc[ai][bj][m][n]; }
    }
};
struct EpiBf16 {
    static constexpr bool LDSW = false; static constexpr bool PRESTAGE = true; static constexpr bool PERM = true; static constexpr int VMOPS = 16;
    bf16_t* O; int ldc;
    __device__ __forceinline__ void operator()(const f32x4 (&acc)[2][2][4][2], const Unit& u, int wr, int wc, int fr, int fq) const {
        const int row0 = u.pm * BM + wr * 64 + fr, col0 = u.pn * BM + wc * 32 + 8 * fq;
#pragma unroll
        for (int ai = 0; ai < 2; ++ai)
#pragma unroll
            for (int m = 0; m < 4; ++m) { bf16_t* rowp = O + (size_t)(row0 + ai * HALF + m * 16) * ldc + col0;
#pragma unroll
                for (int bj = 0; bj < 2; ++bj) { const f32x4 v0 = acc[ai][bj][m][0], v1 = acc[ai][bj][m][1];
                    u32x4 w; w.x = pk_bf16(v0[0], v0[1]); w.y = pk_bf16(v0[2], v0[3]); w.z = pk_bf16(v1[0], v1[1]); w.w = pk_bf16(v1[2], v1[3]);
                    *(u32x4*)(rowp + bj * HALF) = w; } }
    }
};
struct EpiQKV {
    static constexpr bool LDSW = false; static constexpr bool PRESTAGE = true; static constexpr bool PERM = true; static constexpr int VMOPS = 16;
    bf16_t* O; const float* rope;
    __device__ __forceinline__ void operator()(const f32x4 (&acc)[2][2][4][2], const Unit& u, int wr, int wc, int fr, int fq) const {
        const int row0 = u.pm * BM + wr * 64 + fr, col0 = u.pn * BM + wc * 32 + 8 * fq;
        const bool rot = (u.pn < 16) && (u.pm < 64);
        const int axis = wc >> 1, f0 = (wc & 1) * 16 + 4 * fq;
        f32x4 csa[2][4], csb[2][4];
#pragma unroll
        for (int ai = 0; ai < 2; ++ai)
#pragma unroll
            for (int m = 0; m < 4; ++m) { csa[ai][m] = (f32x4){1.f, 0.f, 1.f, 0.f}; csb[ai][m] = (f32x4){1.f, 0.f, 1.f, 0.f};
                if (rot) { const int t = (row0 + ai * HALF + m * 16) & (SEQ - 1); const int pos = axis ? (t & 63) : (t >> 6); const float* rp = rope + ((size_t)pos * 32 + f0) * 2;
                    csa[ai][m] = *(const f32x4*)rp; csb[ai][m] = *(const f32x4*)(rp + 4); } }
        asm volatile("" ::: "memory");
#pragma unroll
        for (int ai = 0; ai < 2; ++ai)
#pragma unroll
            for (int m = 0; m < 4; ++m) { const int row = row0 + ai * HALF + m * 16; bf16_t* rowp = O + (size_t)row * DA_QKVW + col0;
                const f32x4 cs0 = csa[ai][m], cs1 = csb[ai][m];
#pragma unroll
                for (int bj = 0; bj < 2; ++bj) { const f32x4 v0 = acc[ai][bj][m][0], v1 = acc[ai][bj][m][1];
                    f32x4 o0, o1;
                    o0[0] = v0[0] * cs0[0] - v0[1] * cs0[1]; o0[1] = v0[1] * cs0[0] + v0[0] * cs0[1];
                    o0[2] = v0[2] * cs0[2] - v0[3] * cs0[3]; o0[3] = v0[3] * cs0[2] + v0[2] * cs0[3];
                    o1[0] = v1[0] * cs1[0] - v1[1] * cs1[1]; o1[1] = v1[1] * cs1[0] + v1[0] * cs1[1];
                    o1[2] = v1[2] * cs1[2] - v1[3] * cs1[3]; o1[3] = v1[3] * cs1[2] + v1[2] * cs1[3];
                    u32x4 w; w.x = pk_bf16(o0[0], o0[1]); w.y = pk_bf16(o0[2], o0[3]); w.z = pk_bf16(o1[0], o1[1]); w.w = pk_bf16(o1[2], o1[3]);
                    *(u32x4*)(rowp + bj * HALF) = w; } }
    }
};
struct EpiUpAct {
    static constexpr bool LDSW = true; static constexpr bool PRESTAGE = true; static constexpr bool PERM = true; static constexpr int VMOPS = 18;
    bf16_t* ACT; bf16_t* EDGE; const float* cw; LAS unsigned char* wl;
    __device__ __forceinline__ void stage_w(const Unit& u, int buf, int wv) const {
        const int ln = tid_of(wv) & 63;
#pragma unroll
        for (int q = 0; q < 2; ++q) { const int i0 = q ? 512 + (wv & 3) * 64 : wv * 64, k = i0 >> 8, h = (i0 >> 7) & 1, chb = i0 & 127;
            __builtin_amdgcn_global_load_lds((const unsigned*)(cw + (size_t)k * DFF2 + h * DFF + u.pn * 128 + chb + ln), (LAS unsigned*)(wl + buf * 3072 + i0 * 4), 4, 0, 0); }
    }
    __device__ __forceinline__ void run(const f32x4 (&acc)[2][2][4][2], const Unit& u, int wr, int wc, int fr, int fq, int buf) const {
        const int c8 = wc * 32 + 8 * fq; int c0 = u.pn * 128 + c8;
        asm volatile("" : "+v"(c0) :: "memory");
        const bool first = fr == 0, lastr = fr == 15;
        unsigned st[2][4][2];
#pragma unroll
        for (int n = 0; n < 2; ++n) {
            f32x4 wgt[3][2];
#pragma unroll
            for (int k = 0; k < 3; ++k)
#pragma unroll
                for (int h = 0; h < 2; ++h) wgt[k][h] = *(const LAS f32x4*)(wl + buf * 3072 + ((k * 2 + h) * 128 + c8 + 4 * n) * 4);
#pragma unroll
            for (int ai = 0; ai < 2; ++ai) {
                const int rowb = u.pm * BM + ai * HALF + wr * 64;
#pragma unroll
                for (int m = 0; m < 4; ++m) {
                    f32x4 y[2];
#pragma unroll
                    for (int h = 0; h < 2; ++h)
#pragma unroll
                        for (int e = 0; e < 4; ++e) {
                            const float cur = acc[ai][h][m][n][e];
                            const float pin = dpp_f<0x121>(cur), nin = dpp_f<0x12F>(cur);
                            const float pout = m > 0 ? dpp_f<0x121>(acc[ai][h][m > 0 ? m - 1 : 0][n][e]) : 0.f;
                            const float nout = m < 3 ? dpp_f<0x12F>(acc[ai][h][m < 3 ? m + 1 : 3][n][e]) : 0.f;
                            const float pv = first ? pout : pin, nv = lastr ? nout : nin;
                            y[h][e] = wgt[0][h][e] * pv + wgt[1][h][e] * cur + wgt[2][h][e] * nv;
                        }
                    const float o0 = siluf(y[0][0]) * y[1][0], o1 = siluf(y[0][1]) * y[1][1], o2 = siluf(y[0][2]) * y[1][2], o3 = siluf(y[0][3]) * y[1][3];
                    if (n == 0) { st[ai][m][0] = pk_bf16(o0, o1); st[ai][m][1] = pk_bf16(o2, o3); }
                    else { u32x4 pkd; pkd.x = st[ai][m][0]; pkd.y = st[ai][m][1]; pkd.z = pk_bf16(o0, o1); pkd.w = pk_bf16(o2, o3);
                        *(u32x4*)(ACT + (size_t)(rowb + m * 16 + fr) * DFF + c0) = pkd; }
                }
            }
        }
#pragma unroll
        for (int ai = 0; ai < 2; ++ai) {
            const int rowb = u.pm * BM + ai * HALF + wr * 64;
            bf16_t* eb = EDGE + ((size_t)(rowb >> 6) * 4) * DFF2 + (size_t)u.pn * 256 + c8;
#pragma unroll
            for (int mm = 0; mm < 2; ++mm) { const int m = mm ? 3 : 0; const int er = mm ? fr - 12 : fr;
                if (mm ? fr >= 14 : fr < 2) {
                    const f32x4 g0 = acc[ai][0][m][0], g1 = acc[ai][0][m][1], v0 = acc[ai][1][m][0], v1 = acc[ai][1][m][1];
                    u32x4 a, b; a.x = pk_bf16(g0[0], g0[1]); a.y = pk_bf16(g0[2], g0[3]); a.z = pk_bf16(g1[0], g1[1]); a.w = pk_bf16(g1[2], g1[3]);
                    b.x = pk_bf16(v0[0], v0[1]); b.y = pk_bf16(v0[2], v0[3]); b.z = pk_bf16(v1[0], v1[1]); b.w = pk_bf16(v1[2], v1[3]);
                    *(u32x4*)(eb + (size_t)er * DFF2) = a; *(u32x4*)(eb + (size_t)er * DFF2 + 128) = b; } }
        }
    }
};
struct EpiGdnIn {
    static constexpr bool LDSW = false; static constexpr bool PRESTAGE = true; static constexpr bool PERM = true; static constexpr int VMOPS = 16;
    unsigned char* ws; bf16_t* Z; float* AB; bf16_t* EDGE; const float* cw;
    __device__ __forceinline__ void operator()(const f32x4 (&acc)[2][2][4][2], const Unit& u_, int wr, int wc, int fr, int fq) const {
        Unit u; u.pm = __builtin_amdgcn_readfirstlane(u_.pm); u.pn = __builtin_amdgcn_readfirstlane(u_.pn);
        const int row0 = u.pm * BM + wr * 64 + fr, cin = wc * 32 + 8 * fq;
        if (u.pn < 32) {
#pragma unroll
            for (int ai = 0; ai < 2; ++ai) {
                const int rowb = u.pm * BM + ai * HALF + wr * 64;
                bf16_t* eb = EDGE + ((size_t)(rowb >> 6) * 8) * GDN_QKVW + (size_t)u.pn * 256 + cin;
#pragma unroll
                for (int mm = 0; mm < 2; ++mm) { const int m = mm ? 3 : 0; const int er = mm ? fr - 8 : fr;
                    if (mm ? fr >= 12 : fr < 4) {
#pragma unroll
                        for (int bj = 0; bj < 2; ++bj) { const f32x4 v0 = acc[ai][bj][m][0], v1 = acc[ai][bj][m][1];
                            u32x4 w; w.x = pk_bf16(v0[0], v0[1]); w.y = pk_bf16(v0[2], v0[3]); w.z = pk_bf16(v1[0], v1[1]); w.w = pk_bf16(v1[2], v1[3]);
                            *(u32x4*)(eb + (size_t)er * GDN_QKVW + bj * HALF) = w; } } }
            }
            int c0 = u.pn * 256 + cin;
            asm volatile("" : "+v"(c0) :: "memory");
            const bool f1 = fr < 1, f2 = fr < 2, l1 = fr > 14, l2 = fr > 13;
            size_t boff = WS_VN; if (u.pn < 16) boff = WS_KN; if (u.pn < 8) boff = WS_QN;
            bf16_t* base = (bf16_t*)(ws + boff); const int ldc = u.pn < 16 ? 2048 : GDN_VW; const int col0 = (u.pn < 8 ? u.pn : (u.pn < 16 ? u.pn - 8 : u.pn - 16)) * BM + cin;
#pragma unroll
            for (int bj = 0; bj < 2; ++bj) {
                unsigned st[2][4][2];
#pragma unroll
                for (int n = 0; n < 2; ++n) {
                    f32x4 wk[5];
                    const float* wp = cw + c0 + bj * HALF + 4 * n;
#pragma unroll
                    for (int k = 0; k < 5; ++k) wk[k] = *(const f32x4*)(wp + (size_t)k * GDN_QKVW);
#pragma unroll
                    for (int ai = 0; ai < 2; ++ai) {
                        unsigned pkd[4][2];
#pragma unroll
                        for (int ep = 0; ep < 2; ++ep) {
                            float o[4][2];
#pragma unroll
                            for (int eh = 0; eh < 2; ++eh) { const int e = 2 * ep + eh;
                                float d2[4], d1[4], u1[4], u2[4];
#pragma unroll
                                for (int m = 0; m < 4; ++m) { const float cur = acc[ai][bj][m][n][e]; d2[m] = dpp_f<0x122>(cur); d1[m] = dpp_f<0x121>(cur); u1[m] = dpp_f<0x12F>(cur); u2[m] = dpp_f<0x12E>(cur); }
#pragma unroll
                                for (int m = 0; m < 4; ++m) {
                                    const float p2 = f2 ? (m > 0 ? d2[m > 0 ? m - 1 : 0] : 0.f) : d2[m], p1 = f1 ? (m > 0 ? d1[m > 0 ? m - 1 : 0] : 0.f) : d1[m];
                                    const float n1 = l1 ? (m < 3 ? u1[m < 3 ? m + 1 : 3] : 0.f) : u1[m], n2 = l2 ? (m < 3 ? u2[m < 3 ? m + 1 : 3] : 0.f) : u2[m];
                                    const float y = (wk[0][e] * p2 + wk[1][e] * p1) + (wk[2][e] * acc[ai][bj][m][n][e] + wk[3][e] * n1) + wk[4][e] * n2;
                                    o[m][eh] = siluf(y);
                                }
                            }
#pragma unroll
                            for (int m = 0; m < 4; ++m) pkd[m][ep] = pk_bf16(o[m][0], o[m][1]);
                        }
                        if (n == 0) {
#pragma unroll
                            for (int m = 0; m < 4; ++m) { st[ai][m][0] = pkd[m][0]; st[ai][m][1] = pkd[m][1]; }
                        } else {
                            bf16_t* gp = base + (size_t)(row0 + ai * HALF) * ldc + col0 + bj * HALF;
#pragma unroll
                            for (int m = 0; m < 4; ++m) { u32x4 w; w.x = st[ai][m][0]; w.y = st[ai][m][1]; w.z = pkd[m][0]; w.w = pkd[m][1]; *(u32x4*)(gp + (size_t)(m * 16) * ldc) = w; }
                        }
                    }
                }
            }
        } else if (u.pn < 48) {
            bf16_t* base = Z; const int ldc = GDN_VW; const int col0 = (u.pn - 32) * BM + cin;
#pragma unroll
            for (int ai = 0; ai < 2; ++ai)
#pragma unroll
                for (int m = 0; m < 4; ++m) { bf16_t* rowp = base + (size_t)(row0 + ai * HALF + m * 16) * ldc + col0;
#pragma unroll
                    for (int bj = 0; bj < 2; ++bj) { const f32x4 v0 = acc[ai][bj][m][0], v1 = acc[ai][bj][m][1];
                        u32x4 w; w.x = pk_bf16(v0[0], v0[1]); w.y = pk_bf16(v0[2], v0[3]); w.z = pk_bf16(v1[0], v1[1]); w.w = pk_bf16(v1[2], v1[3]);
                        *(u32x4*)(rowp + bj * HALF) = w; } }
        } else {
#pragma unroll
            for (int ai = 0; ai < 2; ++ai)
#pragma unroll
                for (int m = 0; m < 4; ++m) { float* rowp = AB + (size_t)(row0 + ai * HALF + m * 16) * 128 + cin;
                    *(f32x4*)(rowp) = acc[ai][0][m][0]; *(f32x4*)(rowp + 4) = acc[ai][0][m][1]; }
        }
    }
};
}

namespace att {
constexpr int D = 128, NW = 8, QBLK = 32, KVBLK = 64;
constexpr float SCALE = 0.088388347648318440f;
constexpr float THR = 8.f;
constexpr int SHM_V = KVBLK * D * 2, SHM_K = KVBLK * D * 2, SHM_ATTN = 2 * SHM_V + 2 * SHM_K + NW * 64 * 4;
#define KSWZ(row, colB) ((row) * 256 + ((colB) ^ (((row) & 7) << 4)))
#define SBAR() __builtin_amdgcn_sched_barrier(0)
__device__ __forceinline__ int crow(int r, int hi) { return (r & 3) + 8 * (r >> 2) + 4 * hi; }
__device__ __forceinline__ unsigned cvtpk(float lo, float hi) { unsigned r; asm volatile("v_cvt_pk_bf16_f32 %0, %1, %2" : "=v"(r) : "v"(lo), "v"(hi)); return r; }
__device__ __forceinline__ void partialSM(f32x16& p0, f32x16& p1, float& m_reg, float& mn, float& alpha) {
  constexpr float C = SCALE * 1.4426950408889634f;
  float pmax = p0[0];
#pragma unroll
  for (int r = 1; r < 16; ++r) pmax = fmaxf(pmax, p0[r]);
#pragma unroll
  for (int r = 0; r < 16; ++r) pmax = fmaxf(pmax, p1[r]);
  { auto rr = __builtin_amdgcn_permlane32_swap(__float_as_uint(pmax), __float_as_uint(pmax), false, false);
    pmax = fmaxf(__uint_as_float(rr[0]), __uint_as_float(rr[1])); }
  if (__builtin_expect(__all(pmax - m_reg <= THR / SCALE), 1)) { mn = m_reg; alpha = 1.f; }
  else { mn = fmaxf(m_reg, pmax); alpha = __builtin_amdgcn_exp2f((m_reg - mn) * C); m_reg = mn; }
  float mnC = -mn * C;
#pragma unroll
  for (int r = 0; r < 16; ++r) p0[r] = fmaf(p0[r], C, mnC);
#pragma unroll
  for (int r = 0; r < 16; ++r) p1[r] = fmaf(p1[r], C, mnC);
#pragma unroll
  for (int r = 0; r < 16; ++r) p0[r] = __builtin_amdgcn_exp2f(p0[r]);
}
__device__ __forceinline__ void finishSM(f32x16& p0, f32x16& p1, float alpha, float& l_reg, bf16x8& pa0, bf16x8& pa1, bf16x8& pa2, bf16x8& pa3) {
#pragma unroll
  for (int r = 0; r < 16; ++r) p1[r] = __builtin_amdgcn_exp2f(p1[r]);
  float ps = 0;
#pragma unroll
  for (int r = 0; r < 16; ++r) ps += p0[r];
#pragma unroll
  for (int r = 0; r < 16; ++r) ps += p1[r];
  { auto rr = __builtin_amdgcn_permlane32_swap(__float_as_uint(ps), __float_as_uint(ps), false, false);
    ps = __uint_as_float(rr[0]) + __uint_as_float(rr[1]); }
  l_reg = l_reg * alpha + ps;
#define PK4(P, BASE, OUT) do { unsigned a0 = cvtpk(P[BASE + 0], P[BASE + 1]), a1 = cvtpk(P[BASE + 2], P[BASE + 3]);   \
    unsigned b0 = cvtpk(P[BASE + 4], P[BASE + 5]), b1 = cvtpk(P[BASE + 6], P[BASE + 7]);                              \
    auto r0 = __builtin_amdgcn_permlane32_swap(a0, b0, false, false); auto r1 = __builtin_amdgcn_permlane32_swap(a1, b1, false, false); \
    u32x4 w = {r0[0], r1[0], r0[1], r1[1]}; OUT = __builtin_bit_cast(bf16x8, w); } while (0)
  PK4(p0, 0, pa0); PK4(p0, 8, pa1); PK4(p1, 0, pa2); PK4(p1, 8, pa3);
#undef PK4
}
__device__ __forceinline__ void qkt(f32x16& p0, f32x16& p1, const char* Ks, const bf16x8* qr, int r32, int hi) {
#pragma unroll
  for (int r = 0; r < 16; ++r) { p0[r] = 0.f; p1[r] = 0.f; }
#pragma unroll
  for (int d0 = 0; d0 < 8; ++d0) { int cb = (d0 * 16 + hi * 8) * 2;
    bf16x8 b0 = *reinterpret_cast<const bf16x8*>(Ks + KSWZ(r32, cb));
    bf16x8 b1 = *reinterpret_cast<const bf16x8*>(Ks + KSWZ(32 + r32, cb));
    p0 = __builtin_amdgcn_mfma_f32_32x32x16_bf16(b0, qr[d0], p0, 0, 0, 0);
    p1 = __builtin_amdgcn_mfma_f32_32x32x16_bf16(b1, qr[d0], p1, 0, 0, 0); }
}
__device__ __forceinline__ int v_st(int k, int c) { const int kk = (k & ~0xC) | ((k & 4) << 1) | ((k & 8) >> 1); return ((kk >> 3) * 4 + (c >> 5)) * 512 + ((kk & 7) * 32 + (c & 31)) * 2; }
__device__ __forceinline__ int v_rd_base(int lane) { return ((lane & 3) << 3) | (((lane >> 2) & 3) << 6) | (((lane >> 4) & 1) << 5) | (((lane >> 5) & 1) << 8); }
constexpr int v_rd_off(int d0, int ks, int half) { return d0 * 512 + ks * 4096 + half * 2048; }
template <int OFF> __device__ __forceinline__ s16x4 tr_read(int vb) {
  s16x4 r; asm volatile("ds_read_b64_tr_b16 %0, %1 offset:%2" : "=&v"(r) : "v"(vb), "i"(OFF) : "memory"); return r;
}
template <int D0> __device__ __forceinline__ void pv_one(f32x16& od, int vb, bf16x8 pa0, bf16x8 pa1, bf16x8 pa2, bf16x8 pa3) {
  const s16x4 l0 = tr_read<v_rd_off(D0, 0, 0)>(vb), h0 = tr_read<v_rd_off(D0, 0, 1)>(vb), l1 = tr_read<v_rd_off(D0, 1, 0)>(vb), h1 = tr_read<v_rd_off(D0, 1, 1)>(vb);
  const s16x4 l2 = tr_read<v_rd_off(D0, 2, 0)>(vb), h2 = tr_read<v_rd_off(D0, 2, 1)>(vb), l3 = tr_read<v_rd_off(D0, 3, 0)>(vb), h3 = tr_read<v_rd_off(D0, 3, 1)>(vb);
  asm volatile("s_waitcnt lgkmcnt(0)" ::: "memory"); SBAR();
#define PK(L, H) (bf16x8){L[0], L[1], L[2], L[3], H[0], H[1], H[2], H[3]}
  od = __builtin_amdgcn_mfma_f32_32x32x16_bf16(pa0, PK(l0, h0), od, 0, 0, 0);
  od = __builtin_amdgcn_mfma_f32_32x32x16_bf16(pa1, PK(l1, h1), od, 0, 0, 0);
  od = __builtin_amdgcn_mfma_f32_32x32x16_bf16(pa2, PK(l2, h2), od, 0, 0, 0);
  od = __builtin_amdgcn_mfma_f32_32x32x16_bf16(pa3, PK(l3, h3), od, 0, 0, 0);
#undef PK
}
template <int D0> __device__ __forceinline__ void pv_one_lite(f32x16& od, int vb, bf16x8 pa0, bf16x8 pa1, bf16x8 pa2, bf16x8 pa3) {
#define PK(L, H) (bf16x8){L[0], L[1], L[2], L[3], H[0], H[1], H[2], H[3]}
  { const s16x4 l0 = tr_read<v_rd_off(D0, 0, 0)>(vb), h0 = tr_read<v_rd_off(D0, 0, 1)>(vb), l1 = tr_read<v_rd_off(D0, 1, 0)>(vb), h1 = tr_read<v_rd_off(D0, 1, 1)>(vb);
    asm volatile("s_waitcnt lgkmcnt(0)" ::: "memory"); SBAR();
    od = __builtin_amdgcn_mfma_f32_32x32x16_bf16(pa0, PK(l0, h0), od, 0, 0, 0); od = __builtin_amdgcn_mfma_f32_32x32x16_bf16(pa1, PK(l1, h1), od, 0, 0, 0); }
  { const s16x4 l2 = tr_read<v_rd_off(D0, 2, 0)>(vb), h2 = tr_read<v_rd_off(D0, 2, 1)>(vb), l3 = tr_read<v_rd_off(D0, 3, 0)>(vb), h3 = tr_read<v_rd_off(D0, 3, 1)>(vb);
    asm volatile("s_waitcnt lgkmcnt(0)" ::: "memory"); SBAR();
    od = __builtin_amdgcn_mfma_f32_32x32x16_bf16(pa2, PK(l2, h2), od, 0, 0, 0); od = __builtin_amdgcn_mfma_f32_32x32x16_bf16(pa3, PK(l3, h3), od, 0, 0, 0); }
#undef PK
}
__device__ __forceinline__ void pv_d0_lite(f32x16& o0, f32x16& o1, f32x16& o2, f32x16& o3, int vb, bf16x8 pa0, bf16x8 pa1, bf16x8 pa2, bf16x8 pa3) {
  pv_one_lite<0>(o0, vb, pa0, pa1, pa2, pa3); pv_one_lite<1>(o1, vb, pa0, pa1, pa2, pa3); pv_one_lite<2>(o2, vb, pa0, pa1, pa2, pa3); pv_one_lite<3>(o3, vb, pa0, pa1, pa2, pa3);
}
__device__ __forceinline__ void pv_d0(f32x16& o0, f32x16& o1, f32x16& o2, f32x16& o3, int vb, bf16x8 pa0, bf16x8 pa1, bf16x8 pa2, bf16x8 pa3) {
  pv_one<0>(o0, vb, pa0, pa1, pa2, pa3); pv_one<1>(o1, vb, pa0, pa1, pa2, pa3); pv_one<2>(o2, vb, pa0, pa1, pa2, pa3); pv_one<3>(o3, vb, pa0, pa1, pa2, pa3);
}
template <int LDQ, int LDK, int LDO>
__device__ __forceinline__ void attn_body(const bf16_t* __restrict__ Qb, const bf16_t* __restrict__ K0, const bf16_t* __restrict__ V0, int n0,
                                          const bf16_t* __restrict__ K1, const bf16_t* __restrict__ V1, int seq, float* __restrict__ Ob, bool combine, float lam, char* lds, int wv) {
  const int tid = tid_of(wv), wid = wv, lane = tid & 63, r32 = lane & 31, hi = lane >> 5;
  char* V_lds = lds; char* K_lds = lds + 2 * SHM_V;
  float* ws = (float*)(lds + 2 * SHM_V + 2 * SHM_K) + wid * 64; float* li_l = ws; float* al_l = ws + 32;
  float m_reg = -1e30f, l_reg = 0; f32x16 o0, o1, o2, o3; bf16x8 qr[8];
#pragma unroll
  for (int r = 0; r < 16; ++r) { o0[r] = 0.f; o1[r] = 0.f; o2[r] = 0.f; o3[r] = 0.f; }
  const bf16_t* Qw = Qb + (long)(wid * QBLK + r32) * LDQ + hi * 8;
#pragma unroll
  for (int d0 = 0; d0 < 8; ++d0) qr[d0] = *reinterpret_cast<const bf16x8*>(Qw + d0 * 16);
  const int sr = tid >> 4, sc = (tid & 15) * 8, vst0 = v_st(sr, sc), vst1 = v_st(32 + sr, sc);
  const int vb0 = (int)(uintptr_t)V_lds + v_rd_base(lane);
  bf16x8 sE_vs0, sE_vs1, sE_ks0, sE_ks1, sO_vs0, sO_vs1, sO_ks0, sO_ks1;
  const unsigned loff = (unsigned)(sr * LDK + sc) * 2u;
  constexpr long R32 = 32L * LDK * 2;
#define SLOAD(S, k0) do { const int k0_ = (k0); const bool s0_ = k0_ < n0; const long ko_ = (long)(s0_ ? k0_ : k0_ - n0) * (LDK * 2); \
    const char* kp_ = (const char*)(s0_ ? K0 : K1) + ko_; const char* vp_ = (const char*)(s0_ ? V0 : V1) + ko_; \
    S##_vs0 = *reinterpret_cast<const bf16x8*>(vp_ + loff); S##_vs1 = *reinterpret_cast<const bf16x8*>(vp_ + R32 + loff); \
    S##_ks0 = *reinterpret_cast<const bf16x8*>(kp_ + loff); S##_ks1 = *reinterpret_cast<const bf16x8*>(kp_ + R32 + loff); } while (0)
#define SWRITE(b, S) do { *(bf16x8*)(V_lds + (b) * SHM_V + vst0) = S##_vs0; *(bf16x8*)(V_lds + (b) * SHM_V + vst1) = S##_vs1; int kc = sc * 2; \
    *(bf16x8*)(K_lds + (b) * SHM_K + KSWZ(sr, kc)) = S##_ks0; *(bf16x8*)(K_lds + (b) * SHM_K + KSWZ(32 + sr, kc)) = S##_ks1; } while (0)
#define SWAIT() asm volatile("s_waitcnt vmcnt(4)" ::: "memory")
#define RESC(a) do { if (__any((a) < 1.f)) { if (hi == 0) al_l[r32] = (a); asm volatile("s_waitcnt lgkmcnt(0)" ::: "memory"); \
    _Pragma("unroll") for (int r = 0; r < 16; ++r) { const float al_ = al_l[crow(r, hi)]; o0[r] *= al_; o1[r] *= al_; o2[r] *= al_; o3[r] *= al_; } } } while (0)
  f32x16 pA0, pA1, pB0, pB1; float mnA, mnB, alA, alB; bf16x8 pa0, pa1, pa2, pa3; const int NT = seq / KVBLK;
  SLOAD(sE, 0); asm volatile("s_waitcnt vmcnt(0)" ::: "memory"); SWRITE(0, sE); __syncthreads();
  qkt(pA0, pA1, K_lds, qr, r32, hi); partialSM(pA0, pA1, m_reg, mnA, alA);
  SLOAD(sO, KVBLK); if (2 < NT) SLOAD(sE, 2 * KVBLK);
  SWAIT(); SWRITE(1, sO); __syncthreads();
  for (int j = 1; j + 1 < NT; j += 2) {
    SBAR(); qkt(pB0, pB1, K_lds + SHM_K, qr, r32, hi);
    finishSM(pA0, pA1, alA, l_reg, pa0, pa1, pa2, pa3); SBAR();
    SLOAD(sO, (j + 2) * KVBLK); SBAR();
    pv_d0(o0, o1, o2, o3, vb0, pa0, pa1, pa2, pa3); partialSM(pB0, pB1, m_reg, mnB, alB);
    __syncthreads(); SWAIT(); SWRITE(0, sE);
    RESC(alB); __syncthreads();
    SBAR(); qkt(pA0, pA1, K_lds, qr, r32, hi);
    finishSM(pB0, pB1, alB, l_reg, pa0, pa1, pa2, pa3); SBAR();
    if (j + 3 < NT) SLOAD(sE, (j + 3) * KVBLK); SBAR();
    pv_d0(o0, o1, o2, o3, vb0 + SHM_V, pa0, pa1, pa2, pa3); partialSM(pA0, pA1, m_reg, mnA, alA);
    __syncthreads(); SWAIT(); SWRITE(1, sO);
    RESC(alA); __syncthreads();
  }
  SBAR(); qkt(pB0, pB1, K_lds + SHM_K, qr, r32, hi);
  finishSM(pA0, pA1, alA, l_reg, pa0, pa1, pa2, pa3); SBAR();
  pv_d0(o0, o1, o2, o3, vb0, pa0, pa1, pa2, pa3); partialSM(pB0, pB1, m_reg, mnB, alB);
  __syncthreads(); RESC(alB);
  finishSM(pB0, pB1, alB, l_reg, pa0, pa1, pa2, pa3); SBAR();
  pv_d0(o0, o1, o2, o3, vb0 + SHM_V, pa0, pa1, pa2, pa3);
  if (hi == 0) li_l[r32] = l_reg; asm volatile("s_waitcnt lgkmcnt(0)" ::: "memory");
  float* Ow = Ob + (long)(wid * QBLK) * LDO;
#pragma unroll
  for (int r = 0; r < 16; ++r) { const int orow = crow(r, hi); const float rl = __builtin_amdgcn_rcpf(li_l[orow]); float* op = Ow + (long)orow * LDO + r32;
    if (!combine) { op[0] = o0[r] * rl; op[32] = o1[r] * rl; op[64] = o2[r] * rl; op[96] = o3[r] * rl; }
    else { op[0] = o0[r] * rl - lam * op[0]; op[32] = o1[r] * rl - lam * op[32]; op[64] = o2[r] * rl - lam * op[64]; op[96] = o3[r] * rl - lam * op[96]; } }
#undef SLOAD
#undef SWRITE
#undef SWAIT
#undef RESC
}

constexpr int A2_V = 0, A2_K = 4 * SHM_V, A2_W = A2_K + 2 * SHM_K, SHM_ATTN2 = A2_W + NW * 64 * 4;
template <int OFF> __device__ __forceinline__ bf16x8 lds_read128(int addr) { bf16x8 r; asm volatile("ds_read_b128 %0, %1 offset:%2" : "=&v"(r) : "v"(addr), "i"(OFF) : "memory"); return r; }
#define LGKM_WAIT(n) do { asm volatile("s_waitcnt lgkmcnt(" #n ")" ::: "memory"); SBAR(); } while (0)
template <int QD> __device__ __forceinline__ void qkt_pipe(f32x16& p0, f32x16& p1, int kb0, int kb1, int kb2, int kb3, int qdelta) {
#pragma unroll
  for (int r = 0; r < 16; ++r) { p0[r] = 0.f; p1[r] = 0.f; }
#define QK_RD(B0, B1, Q, base, hi128) do { B0 = lds_read128<(hi128) * 128>(base); B1 = lds_read128<(hi128) * 128 + 8192>(base); Q = lds_read128<(hi128) * 128 + QD>((base) + qdelta); } while (0)
#define QK_MM(B0, B1, Q) do { p0 = __builtin_amdgcn_mfma_f32_32x32x16_bf16(B0, Q, p0, 0, 0, 0); p1 = __builtin_amdgcn_mfma_f32_32x32x16_bf16(B1, Q, p1, 0, 0, 0); } while (0)
  bf16x8 a0, a1, aq, b0, b1, bq, c0, c1, cq;
  QK_RD(a0, a1, aq, kb0, 0); QK_RD(b0, b1, bq, kb1, 0);
  QK_RD(c0, c1, cq, kb2, 0); LGKM_WAIT(6); QK_MM(a0, a1, aq);
  QK_RD(a0, a1, aq, kb3, 0); LGKM_WAIT(6); QK_MM(b0, b1, bq);
  QK_RD(b0, b1, bq, kb0, 1); LGKM_WAIT(6); QK_MM(c0, c1, cq);
  QK_RD(c0, c1, cq, kb1, 1); LGKM_WAIT(6); QK_MM(a0, a1, aq);
  QK_RD(a0, a1, aq, kb2, 1); LGKM_WAIT(6); QK_MM(b0, b1, bq);
  QK_RD(b0, b1, bq, kb3, 1); LGKM_WAIT(6); QK_MM(c0, c1, cq);
  LGKM_WAIT(3); QK_MM(a0, a1, aq);
  LGKM_WAIT(0); QK_MM(b0, b1, bq);
#undef QK_RD
#undef QK_MM
}
__device__ __forceinline__ void qkt_pipe_qreg(f32x16& p0, f32x16& p1, int kb0, int kb1, int kb2, int kb3, const bf16x8 (&qr)[8]) {
#pragma unroll
  for (int r = 0; r < 16; ++r) { p0[r] = 0.f; p1[r] = 0.f; }
#define QK_RD(B0, B1, base, hi128) do { B0 = lds_read128<(hi128) * 128>(base); B1 = lds_read128<(hi128) * 128 + 8192>(base); } while (0)
#define QK_MM(B0, B1, Q) do { p0 = __builtin_amdgcn_mfma_f32_32x32x16_bf16(B0, Q, p0, 0, 0, 0); p1 = __builtin_amdgcn_mfma_f32_32x32x16_bf16(B1, Q, p1, 0, 0, 0); } while (0)
  bf16x8 a0, a1, b0, b1, c0, c1;
  QK_RD(a0, a1, kb0, 0); QK_RD(b0, b1, kb1, 0);
  QK_RD(c0, c1, kb2, 0); LGKM_WAIT(4); QK_MM(a0, a1, qr[0]);
  QK_RD(a0, a1, kb3, 0); LGKM_WAIT(4); QK_MM(b0, b1, qr[1]);
  QK_RD(b0, b1, kb0, 1); LGKM_WAIT(4); QK_MM(c0, c1, qr[2]);
  QK_RD(c0, c1, kb1, 1); LGKM_WAIT(4); QK_MM(a0, a1, qr[3]);
  QK_RD(a0, a1, kb2, 1); LGKM_WAIT(4); QK_MM(b0, b1, qr[4]);
  QK_RD(b0, b1, kb3, 1); LGKM_WAIT(4); QK_MM(c0, c1, qr[5]);
  LGKM_WAIT(2); QK_MM(a0, a1, qr[6]);
  LGKM_WAIT(0); QK_MM(b0, b1, qr[7]);
#undef QK_RD
#undef QK_MM
}
__device__ __forceinline__ void pv_pipe(f32x16& o0, f32x16& o1, f32x16& o2, f32x16& o3, f32x16& o4, f32x16& o5, f32x16& o6, f32x16& o7, int vb, bf16x8 pa0, bf16x8 pa1, bf16x8 pa2, bf16x8 pa3) {
#define PV_RD(X, H, D0) do { X##l0 = tr_read<(H) * SHM_V + v_rd_off(D0, 0, 0)>(vb); X##h0 = tr_read<(H) * SHM_V + v_rd_off(D0, 0, 1)>(vb); X##l1 = tr_read<(H) * SHM_V + v_rd_off(D0, 1, 0)>(vb); X##h1 = tr_read<(H) * SHM_V + v_rd_off(D0, 1, 1)>(vb); \
    X##l2 = tr_read<(H) * SHM_V + v_rd_off(D0, 2, 0)>(vb); X##h2 = tr_read<(H) * SHM_V + v_rd_off(D0, 2, 1)>(vb); X##l3 = tr_read<(H) * SHM_V + v_rd_off(D0, 3, 0)>(vb); X##h3 = tr_read<(H) * SHM_V + v_rd_off(D0, 3, 1)>(vb); } while (0)
#define PK(L, H) (bf16x8){L[0], L[1], L[2], L[3], H[0], H[1], H[2], H[3]}
#define PV_MM(X, OD) do { OD = __builtin_amdgcn_mfma_f32_32x32x16_bf16(pa0, PK(X##l0, X##h0), OD, 0, 0, 0); OD = __builtin_amdgcn_mfma_f32_32x32x16_bf16(pa1, PK(X##l1, X##h1), OD, 0, 0, 0); \
    OD = __builtin_amdgcn_mfma_f32_32x32x16_bf16(pa2, PK(X##l2, X##h2), OD, 0, 0, 0); OD = __builtin_amdgcn_mfma_f32_32x32x16_bf16(pa3, PK(X##l3, X##h3), OD, 0, 0, 0); } while (0)
  s16x4 El0, Eh0, El1, Eh1, El2, Eh2, El3, Eh3, Fl0, Fh0, Fl1, Fh1, Fl2, Fh2, Fl3, Fh3;
  PV_RD(E, 0, 0);
  PV_RD(F, 0, 1); LGKM_WAIT(8); PV_MM(E, o0);
  PV_RD(E, 0, 2); LGKM_WAIT(8); PV_MM(F, o1);
  PV_RD(F, 0, 3); LGKM_WAIT(8); PV_MM(E, o2);
  PV_RD(E, 1, 0); LGKM_WAIT(8); PV_MM(F, o3);
  PV_RD(F, 1, 1); LGKM_WAIT(8); PV_MM(E, o4);
  PV_RD(E, 1, 2); LGKM_WAIT(8); PV_MM(F, o5);
  PV_RD(F, 1, 3); LGKM_WAIT(8); PV_MM(E, o6);
  LGKM_WAIT(0); PV_MM(F, o7);
#undef PV_RD
#undef PK
#undef PV_MM
}
template <int LDQ, int LDK, int LDO>
__device__ __forceinline__ void attn_body256(const bf16_t* __restrict__ Qb, const bf16_t* __restrict__ K0, const bf16_t* __restrict__ V0, int n0,
                                             const bf16_t* __restrict__ K1, const bf16_t* __restrict__ V1, int seq, bf16_t* __restrict__ Ob, bool combine, float lam,
                                             bf16_t* __restrict__ Ao, const float* __restrict__ gain, float oml, char* lds, int wv) {
  const int tid = tid_of(wv), wid = wv, lane = tid & 63, r32 = lane & 31, hi = lane >> 5;
  constexpr int SHV2 = 2 * SHM_V;
  float* ws = (float*)(lds + A2_W) + wid * 64; float* li_l = ws; float* al_l = ws + 32;
  float m_reg = -1e30f, l_reg = 0; f32x16 o0, o1, o2, o3, o4, o5, o6, o7;
#pragma unroll
  for (int r = 0; r < 16; ++r) { o0[r] = 0.f; o1[r] = 0.f; o2[r] = 0.f; o3[r] = 0.f; o4[r] = 0.f; o5[r] = 0.f; o6[r] = 0.f; o7[r] = 0.f; }
  const int vb0 = A2_V + v_rd_base(lane);
  const int kbase0 = A2_K + KSWZ(r32, (0 * 16 + hi * 8) * 2), kbase1 = A2_K + KSWZ(r32, (1 * 16 + hi * 8) * 2), kbase2 = A2_K + KSWZ(r32, (2 * 16 + hi * 8) * 2), kbase3 = A2_K + KSWZ(r32, (3 * 16 + hi * 8) * 2);
  bf16x8 qr[8];
  { const bf16_t* Qw = Qb + (long)(wid * QBLK + r32) * LDQ + hi * 8;
#pragma unroll
    for (int d0 = 0; d0 < 8; ++d0) qr[d0] = *reinterpret_cast<const bf16x8*>(Qw + d0 * 16); }
  unsigned kof0, kof1, vof0, vof1;
  {
    const int kb = wid * 2;
    { const int row = kb * 4 + (lane >> 4), cbp = (lane & 15) * 16, cb = cbp ^ ((row & 7) << 4); kof0 = (unsigned)(row * LDK * 2 + cb); }
    { const int row = (kb + 1) * 4 + (lane >> 4), cbp = (lane & 15) * 16, cb = cbp ^ ((row & 7) << 4); kof1 = (unsigned)(row * LDK * 2 + cb); }
    { const int sub = kb * 2 + (lane >> 5), kk = (sub >> 2) * 8 + ((lane & 31) >> 2), k = (kk & ~0xC) | ((kk & 4) << 1) | ((kk & 8) >> 1), c = (sub & 3) * 32 + (lane & 3) * 8; vof0 = (unsigned)(k * LDK * 2 + c * 2); }
    { const int sub = (kb + 1) * 2 + (lane >> 5), kk = (sub >> 2) * 8 + ((lane & 31) >> 2), k = (kk & ~0xC) | ((kk & 4) << 1) | ((kk & 8) >> 1), c = (sub & 3) * 32 + (lane & 3) * 8; vof1 = (unsigned)(k * LDK * 2 + c * 2); }
  }
  LAS unsigned char* ldsl = (LAS unsigned char*)lds;
  const unsigned ldsw = (unsigned)wid * 2048u;
#define TILE_BASES(k0) const int k0_ = (k0); const bool s0_ = k0_ < n0; const long ko_ = (long)(s0_ ? k0_ : k0_ - n0) * (LDK * 2); \
    const char* kp_ = (const char*)(s0_ ? K0 : K1) + ko_; const char* vp_ = (const char*)(s0_ ? V0 : V1) + ko_;
#define DMA16(gp, loff) __builtin_amdgcn_global_load_lds((const unsigned*)(gp), (LAS unsigned*)(ldsl + (loff)), 16, 0, 0)
#define DMA_K(k0, b) do { TILE_BASES(k0) (void)vp_; const unsigned kb_ = A2_K + (b) * SHM_K + ldsw; DMA16(kp_ + kof0, kb_); DMA16(kp_ + kof1, kb_ + 1024); } while (0)
#define DMA_V(k0, b) do { TILE_BASES(k0) (void)kp_; const unsigned vb_ = A2_V + (b) * SHV2 + ldsw; \
    DMA16(vp_ + vof0, vb_); DMA16(vp_ + vof1, vb_ + 1024); DMA16(vp_ + 256 + vof0, vb_ + SHM_V); DMA16(vp_ + 256 + vof1, vb_ + SHM_V + 1024); } while (0)
#define ABAR() do { asm volatile("s_waitcnt lgkmcnt(0)" ::: "memory"); __builtin_amdgcn_s_barrier(); asm volatile("" ::: "memory"); } while (0)
  const int NT = seq / KVBLK;
  DMA_K(0, 0); DMA_V(0, 0);
  if (1 < NT) DMA_K(KVBLK, 1);
  asm volatile("s_waitcnt vmcnt(0)" ::: "memory");
  ABAR();
  const int h1 = wid >> 2;
  f32x16 p0, p1; float mn, al = 1.f; bf16x8 pa0, pa1, pa2, pa3;
#pragma unroll
  for (int r = 0; r < 16; ++r) { p0[r] = 0.f; p1[r] = 0.f; }
  pa0 = pa1 = pa2 = pa3 = (bf16x8){0, 0, 0, 0, 0, 0, 0, 0};
#define ATT_QK(jj) do { const int ko_ = ((jj) & 1) * SHM_K; qkt_pipe_qreg(p0, p1, kbase0 + ko_, kbase1 + ko_, kbase2 + ko_, kbase3 + ko_, qr); } while (0)
#define ATT_SM() do { partialSM(p0, p1, m_reg, mn, al); finishSM(p0, p1, al, l_reg, pa0, pa1, pa2, pa3); \
    if (__any(al < 1.f)) { if (hi == 0) al_l[r32] = al; asm volatile("s_waitcnt lgkmcnt(0)" ::: "memory"); \
      _Pragma("unroll") for (int r = 0; r < 16; ++r) { const float a_ = al_l[crow(r, hi)]; o0[r] *= a_; o1[r] *= a_; o2[r] *= a_; o3[r] *= a_; o4[r] *= a_; o5[r] *= a_; o6[r] *= a_; o7[r] *= a_; } } } while (0)
#define ATT_PV(jj) pv_pipe(o0, o1, o2, o3, o4, o5, o6, o7, vb0 + ((jj) & 1) * SHV2, pa0, pa1, pa2, pa3)
  if (h1) ABAR();
  for (int j = 0; j < NT; ++j) {
    const bool more = j + 1 < NT;
    if (more) { if (!h1) { if (j >= 1) DMA_K((j + 1) * KVBLK, (j + 1) & 1); } else DMA_V((j + 1) * KVBLK, (j + 1) & 1); }
    ATT_QK(j);
    ABAR();
    if (!h1 && more) DMA_V((j + 1) * KVBLK, (j + 1) & 1);
    ATT_SM();
    if (h1) asm volatile("s_waitcnt vmcnt(0)" ::: "memory");
    ABAR();
    if (h1 && j + 2 < NT) DMA_K((j + 2) * KVBLK, j & 1);
    ATT_PV(j);
    if (!h1) asm volatile("s_waitcnt vmcnt(0)" ::: "memory");
    ABAR();
  }
  if (!h1) ABAR();
#undef ATT_QK
#undef ATT_SM
#undef ATT_PV
  {
    if (hi == 0) li_l[r32] = l_reg; asm volatile("s_waitcnt lgkmcnt(0)" ::: "memory");
    bf16_t* Ow = Ob + (long)(wid * QBLK) * LDO;
    if (!combine) {
#pragma unroll
      for (int r = 0; r < 16; ++r) { const int orow = crow(r, hi); const float rl = __builtin_amdgcn_rcpf(li_l[orow]); bf16_t* op = Ow + (long)orow * LDO + r32;
        op[0] = (bf16_t)(pk_bf16(o0[r] * rl, 0.f) & 0xffffu); op[32] = (bf16_t)(pk_bf16(o1[r] * rl, 0.f) & 0xffffu); op[64] = (bf16_t)(pk_bf16(o2[r] * rl, 0.f) & 0xffffu); op[96] = (bf16_t)(pk_bf16(o3[r] * rl, 0.f) & 0xffffu);
        op[128] = (bf16_t)(pk_bf16(o4[r] * rl, 0.f) & 0xffffu); op[160] = (bf16_t)(pk_bf16(o5[r] * rl, 0.f) & 0xffffu); op[192] = (bf16_t)(pk_bf16(o6[r] * rl, 0.f) & 0xffffu); op[224] = (bf16_t)(pk_bf16(o7[r] * rl, 0.f) & 0xffffu); }
    } else {
      float gk[8];
#pragma unroll
      for (int k = 0; k < 8; ++k) gk[k] = gain[r32 + 32 * k] * oml;
      bf16_t* Aw = Ao + (long)(wid * QBLK) * LDO;
#pragma unroll
      for (int r = 0; r < 16; ++r) { const int orow = crow(r, hi); const float rl = __builtin_amdgcn_rcpf(li_l[orow]); const bf16_t* op = Ow + (long)orow * LDO + r32;
        const float d0 = o0[r] * rl - lam * bf2f(op[0]), d1 = o1[r] * rl - lam * bf2f(op[32]), d2 = o2[r] * rl - lam * bf2f(op[64]), d3 = o3[r] * rl - lam * bf2f(op[96]);
        const float d4 = o4[r] * rl - lam * bf2f(op[128]), d5 = o5[r] * rl - lam * bf2f(op[160]), d6 = o6[r] * rl - lam * bf2f(op[192]), d7 = o7[r] * rl - lam * bf2f(op[224]);
        float ss = ((d0 * d0 + d1 * d1) + (d2 * d2 + d3 * d3)) + ((d4 * d4 + d5 * d5) + (d6 * d6 + d7 * d7));
        ss = sum16(ss);
        ss += __builtin_bit_cast(float, __builtin_amdgcn_ds_swizzle(__builtin_bit_cast(int, ss), 0x401F));
        const float rs = 1.0f / sqrtf(ss * (1.0f / 256.0f) + 1e-6f);
        bf16_t* ap = Aw + (long)orow * LDO + r32;
        ap[0] = (bf16_t)(pk_bf16(d0 * rs * gk[0], 0.f) & 0xffffu); ap[32] = (bf16_t)(pk_bf16(d1 * rs * gk[1], 0.f) & 0xffffu); ap[64] = (bf16_t)(pk_bf16(d2 * rs * gk[2], 0.f) & 0xffffu); ap[96] = (bf16_t)(pk_bf16(d3 * rs * gk[3], 0.f) & 0xffffu);
        ap[128] = (bf16_t)(pk_bf16(d4 * rs * gk[4], 0.f) & 0xffffu); ap[160] = (bf16_t)(pk_bf16(d5 * rs * gk[5], 0.f) & 0xffffu); ap[192] = (bf16_t)(pk_bf16(d6 * rs * gk[6], 0.f) & 0xffffu); ap[224] = (bf16_t)(pk_bf16(d7 * rs * gk[7], 0.f) & 0xffffu); }
    }
  }
#undef TILE_BASES
#undef DMA16
#undef DMA_K
#undef DMA_V
#undef ABAR
}
#undef SBAR
}


namespace scan {
constexpr int KIMG = 0, QIMG = 16384, CH0 = 32768, CHSZ = 61440;
constexpr int VIMG = 0, AMAT = 16384, WN = 16384, TP = 32768, TPP = 40960, QKM = 49152, A21I = 57344, T22I = 59392;
constexpr int VEC0 = CH0 + 2 * CHSZ, VECSZ = 1280;
static_assert(VEC0 + 2 * VECSZ <= MISC_OFF, "scan LDS map");
__device__ __forceinline__ int crow(int r, int hi) { return (r & 3) + 8 * (r >> 2) + 4 * hi; }
__device__ __forceinline__ unsigned off_b(unsigned row, unsigned ch) { return 256u * row + 16u * (ch ^ (((row & 3) << 2) | ((row >> 2) & 3))); }
__device__ __forceinline__ unsigned off64(unsigned row, unsigned ch) { return 128u * row + 16u * (ch ^ ((row >> 1) & 7)); }
__device__ __forceinline__ bf16x8 row_frag_b(const LAS unsigned char* img, int lane, int rb, int s) { return *(const LAS bf16x8*)(img + off_b((lane & 31) + 32 * rb, 2 * s + (lane >> 5))); }
__device__ __forceinline__ unsigned off32(unsigned row, unsigned ch) { return 64u * row + 16u * (ch ^ ((row >> 2) & 3)); }
__device__ __forceinline__ bf16x8 row_frag_32(const LAS unsigned char* img, int lane, int s) { return *(const LAS bf16x8*)(img + off32(lane & 31, 2 * s + (lane >> 5))); }
__device__ __forceinline__ bf16x8 row_frag_64(const LAS unsigned char* img, int lane, int rb, int s) { return *(const LAS bf16x8*)(img + off64((lane & 31) + 32 * rb, 2 * s + (lane >> 5))); }
__device__ __forceinline__ bf16x8 tr_frag_b(const LAS unsigned char* img, int lane, int c, int ks) {
    const unsigned h = lane >> 5, blk = (lane >> 4) & 1, q = (lane & 15) >> 2, p = lane & 3;
    const unsigned a0 = off_b(16 * ks + 8 * h + q, 4 * c + 2 * blk + (p >> 1)) + 8 * (p & 1);
    const unsigned a1 = off_b(16 * ks + 8 * h + 4 + q, 4 * c + 2 * blk + (p >> 1)) + 8 * (p & 1);
    const s16x4 lo = __builtin_amdgcn_ds_read_tr16_b64_v4i16((LAS s16x4*)(img + a0)), hi2 = __builtin_amdgcn_ds_read_tr16_b64_v4i16((LAS s16x4*)(img + a1));
    return (bf16x8){lo[0], lo[1], lo[2], lo[3], hi2[0], hi2[1], hi2[2], hi2[3]};
}
template <int BASE> __device__ __forceinline__ bf16x8 pk4(const f32x16& P) {
    const unsigned a0 = pk_bf16(P[BASE + 0], P[BASE + 1]), a1 = pk_bf16(P[BASE + 2], P[BASE + 3]), b0 = pk_bf16(P[BASE + 4], P[BASE + 5]), b1 = pk_bf16(P[BASE + 6], P[BASE + 7]);
    const auto r0 = __builtin_amdgcn_permlane32_swap(a0, b0, false, false); const auto r1 = __builtin_amdgcn_permlane32_swap(a1, b1, false, false);
    const u32x4 w = {r0[0], r1[0], r0[1], r1[1]}; return __builtin_bit_cast(bf16x8, w);
}
#define MFMA32(a, b, c) __builtin_amdgcn_mfma_f32_32x32x16_bf16((a), (b), (c), 0, 0, 0)
__device__ __forceinline__ void zero16(f32x16& x) {
#pragma unroll
    for (int r = 0; r < 16; ++r) x[r] = 0.f;
}

__device__ __forceinline__ u32x4 l2n8(const u32x4 q, float scale) {
    const float y0 = bf_lo(q.x), y1 = bf_hi(q.x), y2 = bf_lo(q.y), y3 = bf_hi(q.y), y4 = bf_lo(q.z), y5 = bf_hi(q.z), y6 = bf_lo(q.w), y7 = bf_hi(q.w);
    float ss = ((y0 * y0 + y1 * y1) + (y2 * y2 + y3 * y3)) + ((y4 * y4 + y5 * y5) + (y6 * y6 + y7 * y7));
    ss = sum16(ss);
    const float rn = scale * __builtin_amdgcn_rsqf(ss + EPS);
    u32x4 o; o.x = pk_bf16(y0 * rn, y1 * rn); o.y = pk_bf16(y2 * rn, y3 * rn); o.z = pk_bf16(y4 * rn, y5 * rn); o.w = pk_bf16(y6 * rn, y7 * rn); return o;
}
__device__ __forceinline__ void gdn_scan(const bf16_t* __restrict__ QN, const bf16_t* __restrict__ KN, const bf16_t* __restrict__ VN, const float* __restrict__ BETA, const float* __restrict__ GG,
                                         bf16_t* __restrict__ OF, bf16_t* __restrict__ OB, bool ctx_out, LAS unsigned char* lds, int bid, int G, int wave) {
    const int cl = wave >> 2, wq = wave & 3;
#define LANES const int tid = tid_of(wave), lane = tid & 63, hi = lane >> 5, r32 = lane & 31; (void)hi; (void)r32;
    LAS unsigned char* chb = lds + CH0 + cl * CHSZ;
    LAS float* vec = (LAS float*)(lds + VEC0 + cl * VECSZ);
    for (int unit = bid; unit < 256; unit += G) {
        const int dir = unit & 1, qh = (unit >> 1) & 15, b = unit >> 5, hh = 2 * qh + cl;
        bf16_t* OUT = dir ? OB : OF;
        f32x16 S0, S1, S2, S3;
        zero16(S0); zero16(S1); zero16(S2); zero16(S3);
        u32x4 pk0, pk1, pq0, pq1, pv0, pv1, pv2, pv3; float pbt = 0.f, pgm = 0.f;
#define SCAN_LOAD(nn) do { LANES const int L_ = (nn) < 4 ? CTXL : SEQ, cn_ = (nn) < 4 ? (nn) : (nn) - 4, rb_ = (nn) < 4 ? NLAT + b * CTXL : b * SEQ; \
            const int r0_ = rb_ + (dir ? L_ - 1 - 64 * cn_ : 64 * cn_), rs_ = dir ? -1 : 1; \
            const int e0 = tid, e1 = tid + 512, i0 = e0 >> 4, i1 = e1 >> 4, c0 = e0 & 15, c1 = e1 & 15, t2 = tid & 255; \
            pk0 = *(const u32x4*)(KN + (size_t)(r0_ + rs_ * i0) * 2048 + qh * 128 + c0 * 8); pk1 = *(const u32x4*)(KN + (size_t)(r0_ + rs_ * i1) * 2048 + qh * 128 + c1 * 8); \
            pq0 = *(const u32x4*)(QN + (size_t)(r0_ + rs_ * i0) * 2048 + qh * 128 + c0 * 8); pq1 = *(const u32x4*)(QN + (size_t)(r0_ + rs_ * i1) * 2048 + qh * 128 + c1 * 8); \
            if (wq == 0) { const size_t gi = (size_t)(r0_ + rs_ * lane) * 64 + dir * 32 + hh; pbt = BETA[gi]; pgm = GG[gi]; } } while (0)
#define SCAN_LOAD_V(nn) do { LANES const int L_ = (nn) < 4 ? CTXL : SEQ, cn_ = (nn) < 4 ? (nn) : (nn) - 4, rb_ = (nn) < 4 ? NLAT + b * CTXL : b * SEQ; \
            const int r0_ = rb_ + (dir ? L_ - 1 - 64 * cn_ : 64 * cn_), rs_ = dir ? -1 : 1; const int t2 = tid & 255; \
            const bf16_t* vb = VN + hh * 128 + (t2 & 15) * 8; \
            pv0 = *(const u32x4*)(vb + (size_t)(r0_ + rs_ * ((t2 >> 4))) * 4096); pv1 = *(const u32x4*)(vb + (size_t)(r0_ + rs_ * ((t2 >> 4) + 16)) * 4096); \
            pv2 = *(const u32x4*)(vb + (size_t)(r0_ + rs_ * ((t2 >> 4) + 32)) * 4096); pv3 = *(const u32x4*)(vb + (size_t)(r0_ + rs_ * ((t2 >> 4) + 48)) * 4096); } while (0)
        SCAN_LOAD(0);
        for (int n = 0; n < 36; ++n) {
            SCAN_LOAD_V(n);
            const int L = n < 4 ? CTXL : SEQ, cn = n < 4 ? n : n - 4, rbase = n < 4 ? NLAT + b * CTXL : b * SEQ;
            const bool want = (n >= 4) || ctx_out;
            const int r0 = rbase + (dir ? L - 1 - 64 * cn : 64 * cn), rs = dir ? -1 : 1;
            { LANES
                if (wq == 0) {
                    const float bt = pbt; float gm = pgm;
                    gm += dpp_f<0x111>(gm); gm += dpp_f<0x112>(gm); gm += dpp_f<0x114>(gm); gm += dpp_f<0x118>(gm);
                    { const float t0 = lane_bcast(gm, 15), t1 = lane_bcast(gm, 31), t2 = lane_bcast(gm, 47); const int rw = lane >> 4;
                      gm += (rw > 0 ? t0 : 0.f) + (rw > 1 ? t1 : 0.f) + (rw > 2 ? t2 : 0.f); }
                    const float glast = lane_bcast(gm, 63);
                    vec[lane] = gm; vec[64 + lane] = __expf(gm); vec[128 + lane] = bt; vec[192 + lane] = __expf(glast - gm);
                    if (lane == 0) vec[256] = __expf(glast);
                }
                { const int e0 = tid, e1 = tid + 512, t2 = tid & 255;
                  pk0 = l2n8(pk0, 1.0f); pk1 = l2n8(pk1, 1.0f); pq0 = l2n8(pq0, 0.08838834764831845f); pq1 = l2n8(pq1, 0.08838834764831845f);
                  *(LAS u32x4*)(lds + KIMG + off_b(e0 >> 4, e0 & 15)) = pk0; *(LAS u32x4*)(lds + KIMG + off_b(e1 >> 4, e1 & 15)) = pk1;
                  *(LAS u32x4*)(lds + QIMG + off_b(e0 >> 4, e0 & 15)) = pq0; *(LAS u32x4*)(lds + QIMG + off_b(e1 >> 4, e1 & 15)) = pq1;
                  (void)t2; }
            }
            __syncthreads();
#define SCAN_BLOCK(WHICH) do { LANES \
                const int blk = wq - 1, rb = blk > 0 ? 1 : 0, cb = blk > 1 ? 1 : 0; \
                f32x16 P; zero16(P); \
                const LAS unsigned char* aimg = lds + ((WHICH) ? QIMG : KIMG); \
                _Pragma("unroll") for (int s = 0; s < 8; ++s) P = MFMA32(row_frag_b(aimg, lane, rb, s), row_frag_b(lds + KIMG, lane, cb, s), P); \
                const int j = 32 * cb + r32; const float gj = vec[j]; \
                  \
                const unsigned jc = (unsigned)j >> 3, jb = (unsigned)(j & 7) * 2u, ib = 32u * rb + 4u * hi; \
                const unsigned abase = (ib * 64u + (unsigned)j) * 4u; \
                const unsigned x21[2] = {256u * hi + 16u * (jc ^ (unsigned)(hi & 3)) + jb, 256u * hi + 16u * (jc ^ (unsigned)((hi + 2) & 3)) + jb};                         \
                const unsigned yq[4] = {128u * ib + 16u * (jc ^ (unsigned)((2 * hi + 0) & 7)) + jb, 128u * ib + 16u * (jc ^ (unsigned)((2 * hi + 1) & 7)) + jb, \
                                        128u * ib + 16u * (jc ^ (unsigned)((2 * hi + 4) & 7)) + jb, 128u * ib + 16u * (jc ^ (unsigned)((2 * hi + 5) & 7)) + jb};     \
                _Pragma("unroll") for (int r = 0; r < 16; r += 2) { const int k = (r & 3) + 8 * (r >> 2); const int i = 32 * rb + crow(r, hi), i1 = i + 1; const float dec = __expf(vec[i] - gj), dec1 = __expf(vec[i1] - gj); \
                    if ((WHICH) == 0) { const float a = vec[128 + i] * P[r] * dec, a1 = vec[128 + i1] * P[r + 1] * dec1;        \
                        if (rb == cb) { *(LAS float*)(chb + AMAT + abase + 256u * k) = a; *(LAS float*)(chb + AMAT + abase + 256u * (k + 1)) = a1; } \
                        else { const unsigned w = pk_bf16(a, a1); const unsigned o = x21[(r >> 2) & 1] + 64u * k; *(LAS bf16_t*)(chb + A21I + o) = (bf16_t)(w & 0xffffu); *(LAS bf16_t*)(chb + A21I + o + 64u) = (bf16_t)(w >> 16); } } \
                    else { const float a = (i >= j) ? P[r] * dec : 0.f, a1 = (i1 >= j) ? P[r + 1] * dec1 : 0.f; const unsigned w = pk_bf16(a, a1); const unsigned o = yq[((r & 3) >> 1) + 2 * ((r >> 2) & 1)] + 128u * k; \
                        *(LAS bf16_t*)(chb + QKM + o) = (bf16_t)(w & 0xffffu); *(LAS bf16_t*)(chb + QKM + o + 128u) = (bf16_t)(w >> 16); } } } while (0)
            bf16x8 ksf0, ksf1, ksf2, ksf3;
            if (wq >= 1) SCAN_BLOCK(0);
            if (wq == 0) { LANES
                const bf16x8 tf0 = pk4<0>(S0), tf1 = pk4<8>(S0), tf2 = pk4<0>(S1), tf3 = pk4<8>(S1), tf4 = pk4<0>(S2), tf5 = pk4<8>(S2), tf6 = pk4<0>(S3), tf7 = pk4<8>(S3);
#define TF(k) ((k) == 0 ? tf0 : (k) == 1 ? tf1 : (k) == 2 ? tf2 : (k) == 3 ? tf3 : (k) == 4 ? tf4 : (k) == 5 ? tf5 : (k) == 6 ? tf6 : tf7)
                f32x16 K0, K1; zero16(K0); zero16(K1);
#pragma unroll
                for (int ks = 0; ks < 8; ++ks) { K0 = MFMA32(row_frag_b(lds + KIMG, lane, 0, ks), TF(ks), K0); K1 = MFMA32(row_frag_b(lds + KIMG, lane, 1, ks), TF(ks), K1); }
#undef TF
#pragma unroll
                for (int r = 0; r < 16; ++r) { K0[r] *= -vec[64 + crow(r, hi)]; K1[r] *= -vec[64 + 32 + crow(r, hi)]; }
                ksf0 = pk4<0>(K0); ksf1 = pk4<8>(K0); ksf2 = pk4<0>(K1); ksf3 = pk4<8>(K1);
            }
            { LANES const int t2 = tid & 255;
              *(LAS u32x4*)(chb + VIMG + off_b((t2 >> 4), t2 & 15)) = pv0; *(LAS u32x4*)(chb + VIMG + off_b((t2 >> 4) + 16, t2 & 15)) = pv1;
              *(LAS u32x4*)(chb + VIMG + off_b((t2 >> 4) + 32, t2 & 15)) = pv2; *(LAS u32x4*)(chb + VIMG + off_b((t2 >> 4) + 48, t2 & 15)) = pv3; }
            __syncthreads();
            if (wq >= 1) SCAN_BLOCK(1);
            if (wq >= 1) { LANES
                const bf16x8 tf0 = pk4<0>(S0), tf1 = pk4<8>(S0), tf2 = pk4<0>(S1), tf3 = pk4<8>(S1), tf4 = pk4<0>(S2), tf5 = pk4<8>(S2), tf6 = pk4<0>(S3), tf7 = pk4<8>(S3);
#define TF(k) ((k) == 0 ? tf0 : (k) == 1 ? tf1 : (k) == 2 ? tf2 : (k) == 3 ? tf3 : (k) == 4 ? tf4 : (k) == 5 ? tf5 : (k) == 6 ? tf6 : tf7)
                f32x16 K0, K1; zero16(K0); zero16(K1);
#pragma unroll
                for (int ks = 0; ks < 8; ++ks) { K0 = MFMA32(row_frag_b(lds + KIMG, lane, 0, ks), TF(ks), K0); K1 = MFMA32(row_frag_b(lds + KIMG, lane, 1, ks), TF(ks), K1); }
#undef TF
#pragma unroll
                for (int r = 0; r < 16; ++r) { K0[r] *= -vec[64 + crow(r, hi)]; K1[r] *= -vec[64 + 32 + crow(r, hi)]; }
                ksf0 = pk4<0>(K0); ksf1 = pk4<8>(K0); ksf2 = pk4<0>(K1); ksf3 = pk4<8>(K1);
            }
#undef SCAN_BLOCK
            if (wq == 0) { LANES
                const int hb = hi, c = r32;
                const LAS float* am = (const LAS float*)(chb + AMAT) + hb * (32 * 64 + 32);
                float t[32];
                typedef float f32x2v __attribute__((ext_vector_type(2)));
                f32x2v tp[16];
                f32x4 ab[2][8];
#pragma unroll
                for (int i = 0; i < 32; ++i) {
                    if (i + 1 < 32) {
#pragma unroll
                        for (int q4 = 0; q4 < 8; ++q4) if (q4 < (i + 1 + 3) / 4) ab[(i + 1) & 1][q4] = *(const LAS f32x4*)(am + (i + 1) * 64 + q4 * 4);
                    }
                    f32x2v acc2 = {(c == i) ? 1.f : 0.f, 0.f};
#pragma unroll
                    for (int k = 0; k < 16; ++k) if (2 * k + 1 < i) { const f32x4 a4 = ab[i & 1][k >> 1]; const f32x2v a2 = (k & 1) ? (f32x2v){a4[2], a4[3]} : (f32x2v){a4[0], a4[1]}; acc2 -= a2 * tp[k]; }
                    float ti = acc2[0] + acc2[1];
                    if (i & 1) ti -= ab[i & 1][(i - 1) >> 2][(i - 1) & 3] * tp[(i - 1) >> 1][0];
                    asm volatile("" : "+v"(ti) :: "memory");
                    tp[i >> 1][i & 1] = ti; t[i] = ti;
                }
                const float bc = vec[128 + 32 * hb + c];
                {
                    const unsigned ch = (unsigned)(32 * hb + c) >> 3, cb2 = (c & 7) * 2, rowb = 128u * 32u * hb;
                    unsigned ox[8];
#pragma unroll
                    for (int k = 0; k < 8; ++k) ox[k] = rowb + 16u * (ch ^ (unsigned)k) + cb2;
#pragma unroll
                    for (int i = 0; i < 32; i += 2) { const unsigned w = pk_bf16(t[i] * bc, t[i + 1] * bc); const unsigned o = ox[(i >> 1) & 7] + 128u * i;
                        *(LAS bf16_t*)(chb + TP + o) = (bf16_t)(w & 0xffffu); *(LAS bf16_t*)(chb + TP + o + 128u) = (bf16_t)(w >> 16); }
                    if (hb) {
#pragma unroll
                        for (int i = 0; i < 32; i += 2) { const unsigned w = pk_bf16(t[i], t[i + 1]);
                            *(LAS bf16_t*)(chb + T22I + off32(i, c >> 3) + (c & 7) * 2) = (bf16_t)(w & 0xffffu); *(LAS bf16_t*)(chb + T22I + off32(i + 1, c >> 3) + (c & 7) * 2) = (bf16_t)(w >> 16); }
                    }
                }
                bf16x8 bf0, bf1;
                {
                    u32x4 w0, w1;
#pragma unroll
                    for (int e = 0; e < 4; ++e) {
                        const unsigned lo0 = pk_bf16(t[2 * e], t[2 * e + 1]), hi0 = pk_bf16(t[8 + 2 * e], t[9 + 2 * e]);
                        const unsigned lo1 = pk_bf16(t[16 + 2 * e], t[17 + 2 * e]), hi1 = pk_bf16(t[24 + 2 * e], t[25 + 2 * e]);
                        const auto s0 = __builtin_amdgcn_permlane32_swap(hi0, hi0, false, false); const auto s1 = __builtin_amdgcn_permlane32_swap(hi1, hi1, false, false);
                        w0[e] = hb ? s0[0] : lo0; w1[e] = hb ? s1[0] : lo1;
                    }
                    bf0 = __builtin_bit_cast(bf16x8, w0); bf1 = __builtin_bit_cast(bf16x8, w1);
                }
                f32x16 M1; zero16(M1);
                M1 = MFMA32(row_frag_32(chb + A21I, lane, 0), bf0, M1); M1 = MFMA32(row_frag_32(chb + A21I, lane, 1), bf1, M1);
                const bf16x8 m0 = pk4<0>(M1), m1 = pk4<8>(M1);
                f32x16 M2; zero16(M2);
                M2 = MFMA32(row_frag_32(chb + T22I, lane, 0), m0, M2); M2 = MFMA32(row_frag_32(chb + T22I, lane, 1), m1, M2);
                const float bc0 = vec[128 + c];
#pragma unroll
                for (int r = 0; r < 16; r += 2) { const unsigned w = pk_bf16(-M2[r] * bc0, -M2[r + 1] * bc0); const unsigned o = off64(32 + crow(r, hi), c >> 3) + (c & 7) * 2;
                    *(LAS bf16_t*)(chb + TP + o) = (bf16_t)(w & 0xffffu); *(LAS bf16_t*)(chb + TP + o + 128u) = (bf16_t)(w >> 16); }
            }
            __syncthreads();
            f32x16 V0, V1;
            { LANES
                zero16(V0); zero16(V1);
#define KSF(k) ((k) == 0 ? ksf0 : (k) == 1 ? ksf1 : (k) == 2 ? ksf2 : ksf3)
#pragma unroll
                for (int ks = 0; ks < 4; ++ks) {
                    const bf16x8 vf = tr_frag_b(chb + VIMG, lane, wq, ks);
                    if (ks < 2) { V0 = MFMA32(row_frag_64(chb + TP, lane, 0, ks), vf, V0); V0 = MFMA32(row_frag_64(chb + TP, lane, 0, ks), KSF(ks), V0); }
                    V1 = MFMA32(row_frag_64(chb + TP, lane, 1, ks), vf, V1); V1 = MFMA32(row_frag_64(chb + TP, lane, 1, ks), KSF(ks), V1);
                }
#undef KSF
            }
            if (n + 1 < 36) SCAN_LOAD(n + 1);
            { LANES
                const bf16x8 sf0 = pk4<0>(S0), sf1 = pk4<8>(S0), sf2 = pk4<0>(S1), sf3 = pk4<8>(S1), sf4 = pk4<0>(S2), sf5 = pk4<8>(S2), sf6 = pk4<0>(S3), sf7 = pk4<8>(S3);
#define SF(k) ((k) == 0 ? sf0 : (k) == 1 ? sf1 : (k) == 2 ? sf2 : (k) == 3 ? sf3 : (k) == 4 ? sf4 : (k) == 5 ? sf5 : (k) == 6 ? sf6 : sf7)
                if (want) { LANES
                    f32x16 O0, O1; zero16(O0); zero16(O1);
#pragma unroll
                    for (int ks = 0; ks < 8; ++ks) { O0 = MFMA32(row_frag_b(lds + QIMG, lane, 0, ks), SF(ks), O0); O1 = MFMA32(row_frag_b(lds + QIMG, lane, 1, ks), SF(ks), O1); }
#pragma unroll
                    for (int r = 0; r < 16; ++r) { O0[r] *= vec[64 + crow(r, hi)]; O1[r] *= vec[64 + 32 + crow(r, hi)]; }
                    const bf16x8 vf0 = pk4<0>(V0), vf1 = pk4<8>(V0), vf2 = pk4<0>(V1), vf3 = pk4<8>(V1);
                    O0 = MFMA32(row_frag_64(chb + QKM, lane, 0, 0), vf0, O0); O0 = MFMA32(row_frag_64(chb + QKM, lane, 0, 1), vf1, O0);
                    O1 = MFMA32(row_frag_64(chb + QKM, lane, 1, 0), vf0, O1); O1 = MFMA32(row_frag_64(chb + QKM, lane, 1, 1), vf1, O1);
                    O1 = MFMA32(row_frag_64(chb + QKM, lane, 1, 2), vf2, O1); O1 = MFMA32(row_frag_64(chb + QKM, lane, 1, 3), vf3, O1);
                    const unsigned ob0 = (unsigned)((r0 + rs * 4 * hi) * 4096 + hh * 128 + 32 * wq + r32) * 2u; const int rstep = rs * 8192;
#pragma unroll
                    for (int r = 0; r < 16; ++r) { const int k = (r & 3) + 8 * (r >> 2); const unsigned w = pk_bf16(O0[r], O1[r]);
                        *(bf16_t*)((char*)OUT + (ob0 + (unsigned)(k * rstep))) = (bf16_t)(w & 0xffffu); *(bf16_t*)((char*)OUT + (ob0 + (unsigned)((32 + k) * rstep))) = (bf16_t)(w >> 16); }
                }
#undef SF
            }
            { LANES
                const float gl = vec[256];
#pragma unroll
                for (int r = 0; r < 16; ++r) { V0[r] *= vec[192 + crow(r, hi)]; V1[r] *= vec[192 + 32 + crow(r, hi)]; S0[r] *= gl; S1[r] *= gl; S2[r] *= gl; S3[r] *= gl; }
                const bf16x8 vf0 = pk4<0>(V0), vf1 = pk4<8>(V0), vf2 = pk4<0>(V1), vf3 = pk4<8>(V1);
#define VF(k) ((k) == 0 ? vf0 : (k) == 1 ? vf1 : (k) == 2 ? vf2 : vf3)
#pragma unroll
                for (int ks = 0; ks < 4; ++ks) {
                    S0 = MFMA32(tr_frag_b(lds + KIMG, lane, 0, ks), VF(ks), S0); S1 = MFMA32(tr_frag_b(lds + KIMG, lane, 1, ks), VF(ks), S1);
                    S2 = MFMA32(tr_frag_b(lds + KIMG, lane, 2, ks), VF(ks), S2); S3 = MFMA32(tr_frag_b(lds + KIMG, lane, 3, ks), VF(ks), S3);
                }
#undef VF
            }
            __syncthreads();
        }
    }
}
#undef MFMA32
#undef SCAN_LOAD
#undef SCAN_LOAD_V
#undef LANES
}

struct Args { const float* in[22]; float* out; unsigned char* ws; int ph_lo, ph_hi, li, pad; };
enum { IN_X = 0, IN_C, IN_CTX, IN_CCTX, IN_WMOD, IN_BMOD, IN_NMIX, IN_NFFN, IN_DAQKV, IN_DALAM, IN_DAGAIN, IN_DAWO, IN_GWIN, IN_GCONV, IN_GALOG, IN_GDT, IN_GGAIN, IN_GWO, IN_FUP, IN_FCONV, IN_FDN, IN_FNORM };
constexpr int NWAVES = 8, NTHR = 512;

__device__ __forceinline__ int rope_dst(int n) { const int d = n & 127, a = d >> 6, j = d & 63, hi = j >> 5, f = j & 31; return (n & ~127) + a * 64 + 2 * f + hi; }
__device__ __forceinline__ int up_dst(int n) { const int half = n >= DFF ? 1 : 0, rem = n - half * DFF; return (rem >> 7) * 256 + half * 128 + (rem & 127); }
__device__ __forceinline__ void transpose_item(const float* W, int K, int N, bf16_t* WT, int ropelim, LAS float* scr, int item, int lane) {
    const int nblk = N / 32, kb = item / nblk, nb = item % nblk, k0 = 64 * kb, n0 = 32 * nb;
#pragma unroll 8
    for (int i = 0; i < 32; ++i) { const int kk = 2 * i + (lane >> 5); scr[kk * 33 + (lane & 31)] = W[(size_t)(k0 + kk) * N + n0 + (lane & 31)]; }
    asm volatile("s_waitcnt lgkmcnt(0)" ::: "memory");
    const int c = lane & 7;
#pragma unroll
    for (int j = 0; j < 4; ++j) { const int n = (lane >> 3) + 8 * j; const LAS float* s = scr + (8 * c) * 33 + n;
        u32x4 o; o.x = pk_bf16(s[0 * 33], s[1 * 33]); o.y = pk_bf16(s[2 * 33], s[3 * 33]); o.z = pk_bf16(s[4 * 33], s[5 * 33]); o.w = pk_bf16(s[6 * 33], s[7 * 33]);
        const int ns = n0 + n, nd = ropelim < 0 ? up_dst(ns) : (ns < ropelim ? rope_dst(ns) : ns);
        *(u32x4*)(WT + (size_t)nd * K + k0 + 8 * c) = o; }
    asm volatile("s_waitcnt lgkmcnt(0)" ::: "memory");
}
__device__ __forceinline__ void transpose_matrix(const float* W, int K, int N, bf16_t* WT, int ropelim, LAS float* scr, int gw, int NGW, int lane) {
    const int nitems = (K / 64) * (N / 32);
    for (int it = gw; it < nitems; it += NGW) transpose_item(W, K, N, WT, ropelim, scr, it, lane);
}

__device__ __forceinline__ void norm_row_load(const float* inL, const float* inC, const bf16_t* X, bool from_in, int row, int lane, f32x4 (&v)[8]) {
    if (from_in) {
        const f32x4* xs = (const f32x4*)(row < NLAT ? inL + (size_t)row * DM : inC + (size_t)(row - NLAT) * DM) + lane;
#pragma unroll
        for (int j = 0; j < 8; ++j) v[j] = xs[64 * j];
    } else {
        const u32x2* xs = (const u32x2*)(X + (size_t)row * DM) + lane;
        u32x2 q[8];
#pragma unroll
        for (int j = 0; j < 8; ++j) q[j] = xs[64 * j];
#pragma unroll
        for (int j = 0; j < 8; ++j) v[j] = (f32x4){xs_lo(q[j].x), xs_hi(q[j].x), xs_lo(q[j].y), xs_hi(q[j].y)};
    }
}
__device__ __forceinline__ void norm_row_finish(f32x4 (&v)[8], bf16_t* X, bool from_in, const float* w, const float* mod_shift, const float* mod_scale, bf16_t* H, int row, const float* part, const float* pgate, int lane) {
    const int mr = row < NLAT ? (row >> 11) : 8;
    const bool fold = part != nullptr && row >= NLAT;
    if (fold) {
        const int tr = (row - NLAT) >> 8, rr = (row - NLAT) & 255;
#pragma unroll
        for (int j = 0; j < 8; ++j) {
            const float* pp = part + ((size_t)((tr * 8 + j) * 4) * 256 + rr) * 256 + lane * 4;
            const f32x4 p0 = *(const f32x4*)pp, p1 = *(const f32x4*)(pp + 65536), p2 = *(const f32x4*)(pp + 2 * 65536), p3 = *(const f32x4*)(pp + 3 * 65536);
            const f32x4 gt = *((const f32x4*)(pgate + (size_t)8 * MODW) + lane + 64 * j);
            v[j] += gt * (((p0 + p1) + p2) + p3);
        }
    }
    if (fold || from_in) {
        u32x2* xr = (u32x2*)(X + (size_t)row * DM) + lane;
#pragma unroll
        for (int j = 0; j < 8; ++j) { u32x2 o; o.x = pk_xs(v[j][0], v[j][1]); o.y = pk_xs(v[j][2], v[j][3]); xr[64 * j] = o;
            v[j] = (f32x4){xs_lo(o.x), xs_hi(o.x), xs_lo(o.y), xs_hi(o.y)}; }
    }
    float s = 0.f;
#pragma unroll
    for (int j = 0; j < 8; ++j) s += (v[j][0] * v[j][0] + v[j][1] * v[j][1]) + (v[j][2] * v[j][2] + v[j][3] * v[j][3]);
    const float rstd = 1.0f / sqrtf(wave_sum(s) * (1.0f / DM) + EPS);
    const f32x4* wp = (const f32x4*)w + lane; const f32x4* shp = (const f32x4*)(mod_shift + (size_t)mr * MODW) + lane; const f32x4* scp = (const f32x4*)(mod_scale + (size_t)mr * MODW) + lane;
    u32x2* op = (u32x2*)(H + (size_t)row * DM) + lane;
#pragma unroll
    for (int j = 0; j < 8; ++j) { const f32x4 ww = wp[64 * j], sh = shp[64 * j], sc = scp[64 * j];
        f32x4 y;
#pragma unroll
        for (int e = 0; e < 4; ++e) y[e] = (v[j][e] * rstd * ww[e]) * (1.0f + sc[e]) + sh[e];
        u32x2 o; o.x = pk_bf16(y[0], y[1]); o.y = pk_bf16(y[2], y[3]); op[64 * j] = o; }
}
__device__ __forceinline__ void norm_mod_phase(const float* inL, const float* inC, bf16_t* X, bool from_in, const float* w, const float* mod_shift, const float* mod_scale, bf16_t* H, int nrows, const float* part, const float* pgate, int gw, int NGW, int lane) {
    for (int row = gw; row < nrows; row += 2 * NGW) {
        const int row2 = row + NGW; const bool two = row2 < nrows;
        f32x4 va[8], vb[8];
        norm_row_load(inL, inC, X, from_in, row, lane, va);
        if (two) norm_row_load(inL, inC, X, from_in, row2, lane, vb);
        norm_row_finish(va, X, from_in, w, mod_shift, mod_scale, H, row, part, pgate, lane);
        if (two) norm_row_finish(vb, X, from_in, w, mod_shift, mod_scale, H, row2, part, pgate, lane);
    }
}

#define CAS __attribute__((address_space(4)))
__device__ __forceinline__ const CAS Args* kargs() { const CAS Args* p = (const CAS Args*)__builtin_amdgcn_kernarg_segment_ptr(); asm volatile("" : "+s"(p)); return p; }
__global__ void __launch_bounds__(NTHR, 2) fwd(Args args_unused) {
    extern __shared__ __attribute__((aligned(16))) unsigned char lds_raw[];
    LAS unsigned char* lds = (LAS unsigned char*)lds_raw;
    volatile LAS unsigned* MISC = (volatile LAS unsigned*)(lds + MISC_OFF);
    const int G = gridDim.x, bid = blockIdx.x, NGW = G * NWAVES;
    const int wave_s = __builtin_amdgcn_readfirstlane(threadIdx.x >> 6);
    if (threadIdx.x < 64) MISC[threadIdx.x] = 0u;
    __syncthreads();
    XcdBarrier bar; { const CAS Args* ka0 = kargs(); bar.bar = (unsigned*)(ka0->ws + WS_CTL); bar.x = 0; bar.st = MISC; }
    if (MK_SINGLE) bar = xcd_barrier_post(bar.bar, MISC);
    int lo, hi; { const CAS Args* ka0 = kargs(); lo = ka0->ph_lo; hi = ka0->ph_hi; }
#ifndef PH_MASK
#define PH_MASK 0xffffu
#endif
#define EN(t) (((PH_MASK) >> (t)) & 1u)
#ifndef DUP_MASK
#define DUP_MASK 0u
#endif
#define NREP(t) ((((DUP_MASK) >> (t)) & 1u) ? 2 : 1)
#define IN(k) (lo <= (k) && (k) < hi)
#define SEAM(k) do { if (MK_SINGLE && (k) + 1 < hi) xcd_barrier(bar); } while (0)

#define PH_BEGIN const int wave = wave_s, tid = tid_of(wave), lane = tid & 63, gw = bid * NWAVES + wave; (void)lane; (void)gw; const CAS Args* ka = kargs(); unsigned char* ws = ka->ws; float* MOD = (float*)(ws + WS_MOD); bf16_t* X = (bf16_t*)(ws + WS_X); bf16_t* H = (bf16_t*)(ws + WS_H); \
    const float* ROPE = (const float*)(ws + WS_ROPE); float* LAM = (float*)(ws + WS_LAM); (void)MOD; (void)X; (void)H; (void)ROPE; (void)LAM;
#define PH_BEGIN_L PH_BEGIN const float* modl = MOD + (size_t)l * 9 * MODW; (void)modl;

    if (EN(0) && IN(0)) for (int rep_ = 0; rep_ < NREP(0); ++rep_) { PH_BEGIN
        LAS float* scr = (LAS float*)(lds + wave * 16384);
        for (int j = 0; j < 2; ++j) {
            transpose_matrix(ka->in[IN_DAQKV] + (size_t)j * DM * DA_QKVW, DM, DA_QKVW, (bf16_t*)(ws + WS_WQKV) + (size_t)j * DA_QKVW * DM, 4096, scr, gw, NGW, lane);
            transpose_matrix(ka->in[IN_DAWO] + (size_t)j * DM * DM, DM, DM, (bf16_t*)(ws + WS_WODA) + (size_t)j * DM * DM, 0, scr, gw, NGW, lane);
            transpose_matrix(ka->in[IN_GWIN] + (size_t)j * DM * GDN_INW, DM, GDN_INW, (bf16_t*)(ws + WS_WIN) + (size_t)j * GDN_INW_PAD * DM, 0, scr, gw, NGW, lane);
            transpose_matrix(ka->in[IN_GWO] + (size_t)j * GDN_VW * DM, GDN_VW, DM, (bf16_t*)(ws + WS_WOG) + (size_t)j * DM * GDN_VW, 0, scr, gw, NGW, lane);
        }
        {
            const int l = 0;
            transpose_matrix(ka->in[IN_FUP] + (size_t)l * DM * DFF2, DM, DFF2, (bf16_t*)(ws + WS_WUP) + (size_t)l * DFF2 * DM, -1, scr, gw, NGW, lane);
            transpose_matrix(ka->in[IN_FDN] + (size_t)l * DFF * DM, DFF, DM, (bf16_t*)(ws + WS_WDN) + (size_t)l * DM * DFF, 0, scr, gw, NGW, lane);
        }
        __syncthreads();
        {
            LAS float* sc = (LAS float*)lds;
            LAS float* red = (LAS float*)(lds + 73728);
            if (bid < DEPTH * 48) {
                for (int i = tid; i < 9 * DM; i += NTHR) { const int r = i >> 11, k = i & (DM - 1); const float cv = r < 8 ? ka->in[IN_C][r * DM + k] : ka->in[IN_CCTX][k]; sc[i] = siluf(cv); }
                __syncthreads();
                for (int task = bid; task < DEPTH * 48; task += G) {
                    const int l = task / 48, cb = task % 48;
                    const float* wp = ka->in[IN_WMOD] + ((size_t)l * DM + wave * 256) * MODW + cb * 256 + lane * 4;
                    f32x4 acc[9];
#pragma unroll
                    for (int r = 0; r < 9; ++r) acc[r] = (f32x4){0.f, 0.f, 0.f, 0.f};
                    for (int k = 0; k < 256; k += 4) {
                        const f32x4 w0 = *(const f32x4*)(wp + (size_t)(k + 0) * MODW), w1 = *(const f32x4*)(wp + (size_t)(k + 1) * MODW), w2 = *(const f32x4*)(wp + (size_t)(k + 2) * MODW), w3 = *(const f32x4*)(wp + (size_t)(k + 3) * MODW);
#pragma unroll
                        for (int r = 0; r < 9; ++r) { const f32x4 s4 = *(const LAS f32x4*)(sc + r * DM + wave * 256 + k); acc[r] += s4[0] * w0 + s4[1] * w1 + s4[2] * w2 + s4[3] * w3; }
                    }
#pragma unroll
                    for (int r = 0; r < 9; ++r) *(LAS f32x4*)(red + (wave * 9 + r) * 256 + lane * 4) = acc[r];
                    __syncthreads();
                    for (int o = tid; o < 9 * 256; o += NTHR) { const int r = o >> 8, c = o & 255; float sum = ka->in[IN_BMOD][l * MODW + cb * 256 + c];
#pragma unroll
                        for (int w = 0; w < 8; ++w) sum += red[(w * 9 + r) * 256 + c];
                        MOD[((size_t)l * 9 + r) * MODW + cb * 256 + c] = sum; }
                    __syncthreads();
                }
            }
        }
        if (bid == 0) {
            float* rp = (float*)(ws + WS_ROPE);
            for (int i = tid; i < 64 * 32; i += NTHR) { const int pos = i >> 5, f = i & 31; const float inv = exp2f(-(float)f * (13.287712379549449f / 32.0f)); const float ang = (float)pos * inv;
                rp[2 * i] = __cosf(ang); rp[2 * i + 1] = __sinf(ang); }
        }
        if (bid == 1 && wave < 2) {
            const float* lv = ka->in[IN_DALAM] + wave * 512;
            const float s01 = wave_sum(lv[lane] * lv[128 + lane] + lv[64 + lane] * lv[192 + lane]);
            const float s23 = wave_sum(lv[256 + lane] * lv[384 + lane] + lv[320 + lane] * lv[448 + lane]);
            if (lane == 0) LAM[wave] = __expf(s01) - __expf(s23) + (wave == 0 ? LAMBDA_INIT0 : LAMBDA_INIT2);
        }
        SEAM(0);
    }

    for (int l = 0; l < DEPTH; ++l) {
        const int pb = 1 + 10 * l, j = l >> 1;
        const bool last = (l == DEPTH - 1), gdn = (l & 1);
        const int nrows_out = last ? NLAT : NTOK;

        if (EN(1) && IN(pb + 0)) for (int rep_ = 0; rep_ < NREP(1); ++rep_) { PH_BEGIN_L norm_mod_phase(ka->in[IN_X], ka->in[IN_CTX], X, l == 0, ka->in[IN_NMIX] + l * DM, modl + 0 * DM, modl + 1 * DM, H, NTOK, l > 0 ? (const float*)(ws + WS_PART) : nullptr, MOD + (size_t)(l > 0 ? l - 1 : 0) * 9 * MODW + 5 * DM, gw, NGW, lane); SEAM(pb + 0); }

        if (!gdn) {
            if (EN(2) && IN(pb + 1)) for (int rep_ = 0; rep_ < NREP(2); ++rep_) { PH_BEGIN_L
                pg8::Gemm g{H, (const bf16_t*)(ws + WS_WQKV) + (size_t)j * DA_QKVW * DM, NTOK, DA_QKVW, DM, DM, DM}; pg8::StaticOrder S; S.init(NTOK, DA_QKVW, G, bid);
                pg8::EpiQKV E{(bf16_t*)(ws + WS_QKV), ROPE};
                pg8::gemm_phase<pg8::EpiQKV, pg8::StaticOrder>(lds, g, S, E, wave);
                SEAM(pb + 1);
            }
            if (EN(3) && IN(pb + 3)) for (int rep_ = 0; rep_ < NREP(3); ++rep_) { PH_BEGIN_L
                const bf16_t* QKV = (const bf16_t*)(ws + WS_QKV); bf16_t* O2B = (bf16_t*)(ws + WS_DIFF);
                const float lam = LAM[j];
                const float oml = 1.0f - (j == 0 ? LAMBDA_INIT0 : LAMBDA_INIT2);
                const float* gainp = ka->in[IN_DAGAIN] + j * 256;
                bf16_t* AO = (bf16_t*)(ws + WS_AO);
                const int nunits = 512 + 64;
                const int vid = (G % 8 == 0) ? (bid & 7) * (G >> 3) + (bid >> 3) : bid;
                for (int it = 0;; ++it) {
                    const int u = vid + (it >> 1) * G; if (u >= nunits) break;
                    const int comp = 1 - (it & 1), vh = 0;
                    int b, h, qrow0, n0, seq; const bf16_t *kv0, *kv1;
                    if (u < 512) { b = u >> 6; h = (u >> 3) & 7; const int qb = u & 7; qrow0 = b * SEQ + qb * 256;
                        kv0 = QKV + (size_t)(b * SEQ) * DA_QKVW; n0 = SEQ; kv1 = QKV + (size_t)(NLAT + b * CTXL) * DA_QKVW; seq = SEQ + CTXL; }
                    else { const int v = u - 512; b = v >> 3; h = v & 7; qrow0 = NLAT + b * CTXL;
                        kv0 = QKV + (size_t)(NLAT + b * CTXL) * DA_QKVW; n0 = CTXL; kv1 = kv0; seq = CTXL; }
                    bf16_t* ob = O2B + (size_t)qrow0 * DM + h * 256 + vh * 128; bf16_t* ao = AO + (size_t)qrow0 * DM + h * 256 + vh * 128;
                    const int kcol = 2048 + h * 256 + comp * 128, vcol = 4096 + h * 256 + vh * 128;
                    __syncthreads();
                    att::attn_body256<DA_QKVW, DA_QKVW, DM>(QKV + (size_t)qrow0 * DA_QKVW + h * 256 + comp * 128, kv0 + kcol, kv0 + vcol, n0, kv1 + kcol, kv1 + vcol, seq, ob, comp == 0, lam, ao, gainp, oml, (char*)lds_raw, wave);
                }
                SEAM(pb + 3);
            }
            if (EN(5) && IN(pb + 5)) for (int rep_ = 0; rep_ < NREP(5); ++rep_) { PH_BEGIN_L
                {
                    const bf16_t* Ap = (const bf16_t*)(ws + WS_AO); const bf16_t* Bp = (const bf16_t*)(ws + WS_WODA) + (size_t)j * DM * DM; const int KK = DM;
                    pg8::Gemm g{Ap, Bp, NLAT, DM, KK, KK, KK}; pg8::StaticOrder S; S.init(NLAT, DM, G, bid);
                    pg8::EpiResid E{X, modl + 2 * DM};
                    pg8::gemm_phase<pg8::EpiResid, pg8::StaticOrder>(lds, g, S, E, wave);
                    if (NTOK > NLAT) {
                        for (int sub = bid; sub < 256; sub += G) {
                        const int kq = sub & 3, k128 = KK / 128, kb = (k128 * kq) / 4, ke = (k128 * (kq + 1)) / 4;
                        pg8::Gemm g2{Ap + kb * 128, Bp + kb * 128, NTOK, DM, (ke - kb) * 128, KK, KK}; pg8::TailOrder T{sub};
                        pg8::EpiPartial E2{(float*)(ws + WS_PART) + (size_t)sub * 65536};
                        pg8::gemm_phase<pg8::EpiPartial, pg8::TailOrder>(lds, g2, T, E2, wave); }
                    }
                }
                SEAM(pb + 5);
            }
        } else {
            if (EN(6) && IN(pb + 1)) for (int rep_ = 0; rep_ < NREP(6); ++rep_) { PH_BEGIN_L
                pg8::Gemm g{H, (const bf16_t*)(ws + WS_WIN) + (size_t)j * GDN_INW_PAD * DM, NTOK, GDN_INW_PAD, DM, DM, DM}; pg8::StaticOrder S; S.init(NTOK, GDN_INW_PAD, G, bid);
                pg8::EpiGdnIn E{ws, (bf16_t*)(ws + WS_Z), (float*)(ws + WS_AB), (bf16_t*)(ws + WS_GEDGE), ka->in[IN_GCONV] + (size_t)j * 5 * GDN_QKVW};
                pg8::gemm_phase<pg8::EpiGdnIn, pg8::StaticOrder>(lds, g, S, E, wave);
                SEAM(pb + 1);
            }
            if (EN(7) && IN(pb + 2)) for (int rep_ = 0; rep_ < NREP(7); ++rep_) { PH_BEGIN_L
                const bf16_t* EDGE = (const bf16_t*)(ws + WS_GEDGE); const float* AB = (const float*)(ws + WS_AB);
                bf16_t* QN = (bf16_t*)(ws + WS_QN); bf16_t* KN = (bf16_t*)(ws + WS_KN); bf16_t* VN = (bf16_t*)(ws + WS_VN);
                float* BETA = (float*)(ws + WS_BETA); float* GG = (float*)(ws + WS_G);
                const float* cw = ka->in[IN_GCONV] + (size_t)j * 5 * GDN_QKVW;
                const int ngroups = (NTOK / 64) * 4 * 64;
                for (int gidx = (bid * NTHR + tid) >> 4; gidx < ngroups; gidx += (G * NTHR) >> 4) {
                    const int cg = gidx & 63, r4 = (gidx >> 6) & 3, blk = gidx >> 8;
                    const int r = r4 < 2 ? r4 : 60 + r4, row = blk * 64 + r;
                    const int seqlen = row < NLAT ? SEQ : CTXL; const int t = row < NLAT ? (row & (SEQ - 1)) : ((row - NLAT) & (CTXL - 1));
                    const int ch0 = cg * 128 + (tid & 15) * 8;
                    float y[8];
#pragma unroll
                    for (int e = 0; e < 8; ++e) y[e] = 0.f;
#pragma unroll
                    for (int k = 0; k < 5; ++k) {
                        const int tr = r + k - 2, tt = t + k - 2; const bool ok = (tt >= 0) && (tt < seqlen);
                        const int sb = tr < 0 ? blk - 1 : (tr >= 64 ? blk + 1 : blk), idx = tr < 0 ? 8 + tr : (tr >= 64 ? tr - 64 : (tr < 4 ? tr : tr - 56));
                        const u32x4 q = ok ? *(const u32x4*)(EDGE + ((size_t)sb * 8 + idx) * GDN_QKVW + ch0) : (u32x4){0u, 0u, 0u, 0u};
                        const f32x4 wa = *(const f32x4*)(cw + (size_t)k * GDN_QKVW + ch0), wb = *(const f32x4*)(cw + (size_t)k * GDN_QKVW + ch0 + 4);
                        y[0] += wa[0] * bf_lo(q.x); y[1] += wa[1] * bf_hi(q.x); y[2] += wa[2] * bf_lo(q.y); y[3] += wa[3] * bf_hi(q.y);
                        y[4] += wb[0] * bf_lo(q.z); y[5] += wb[1] * bf_hi(q.z); y[6] += wb[2] * bf_lo(q.w); y[7] += wb[3] * bf_hi(q.w);
                    }
#pragma unroll
                    for (int e = 0; e < 8; ++e) y[e] = siluf(y[e]);
                    bf16_t* dst;
                    if (cg < 32) dst = (cg < 16 ? QN : KN) + (size_t)row * 2048 + (cg & 15) * 128 + (tid & 15) * 8;
                    else dst = VN + (size_t)row * 4096 + (cg - 32) * 128 + (tid & 15) * 8;
                    u32x4 ov; ov.x = pk_bf16(y[0], y[1]); ov.y = pk_bf16(y[2], y[3]); ov.z = pk_bf16(y[4], y[5]); ov.w = pk_bf16(y[6], y[7]);
                    *(u32x4*)dst = ov;
                }
                {
                    const int c = tid & 63, dir = c >> 5, hh = c & 31;
                    const float A = __expf(ka->in[IN_GALOG][j * 64 + c]), dtb = ka->in[IN_GDT][j * 64 + c];
                    for (int i = bid * NTHR + tid; i < NTOK * 64; i += G * NTHR) { const int row = i >> 6;
                        const float* ab = AB + (size_t)row * 128 + dir * 64;
                        const float xb = ab[hh], xd = ab[32 + hh] + dtb;
                        const float sp = fmaxf(xd, 0.f) + log1pf(__expf(-fabsf(xd)));
                        BETA[(size_t)row * 64 + c] = 1.0f / (1.0f + __expf(-xb)); GG[(size_t)row * 64 + c] = -A * sp; }
                }
                SEAM(pb + 2);
            }
            if (EN(8) && IN(pb + 3)) for (int rep_ = 0; rep_ < NREP(8); ++rep_) { PH_BEGIN_L
                const bf16_t* QN = (const bf16_t*)(ws + WS_QN); const bf16_t* KN = (const bf16_t*)(ws + WS_KN); const bf16_t* VN = (const bf16_t*)(ws + WS_VN);
                const float* BETA = (const float*)(ws + WS_BETA); const float* GG = (const float*)(ws + WS_G);
                bf16_t* OF = (bf16_t*)(ws + WS_OF); bf16_t* OB = (bf16_t*)(ws + WS_OB);
#if SCAN_NAIVE
                LAS float* kq = (LAS float*)lds;
                LAS float* part = (LAS float*)(lds + 4096);
                const int cl = tid >> 8, t2 = tid & 255, c = t2 & 127, hf = t2 >> 7;
                for (int ch = bid * 2 + cl; ch < 512 + cl; ch += 2 * G) {
                    const bool live = ch < 512; const int chn = live ? ch : 0;
                    const int dir = chn & 1, hh = (chn >> 1) & 31, b = chn >> 6, qh = hh >> 1;
                    float S[64];
#pragma unroll
                    for (int i = 0; i < 64; ++i) S[i] = 0.f;
                    bf16_t* OUT = dir ? OB : OF;
                    for (int seg = 0; seg < 2; ++seg) {
                        const int L = seg == 0 ? CTXL : SEQ; const int rbase = seg == 0 ? NLAT + b * CTXL : b * SEQ;
                        const bool want = live && (seg == 1 || !last);
                        for (int p = 0; p < L; ++p) {
                            const int row = rbase + (dir ? L - 1 - p : p);
                            if (hf == 0) { kq[cl * 256 + c] = bf2f(KN[(size_t)row * 2048 + qh * 128 + c]); } else { kq[cl * 256 + 128 + c] = bf2f(QN[(size_t)row * 2048 + qh * 128 + c]); }
                            const float vv = bf2f(VN[(size_t)row * 4096 + hh * 128 + c]);
                            const float bt = BETA[(size_t)row * 64 + dir * 32 + hh], a = __expf(GG[(size_t)row * 64 + dir * 32 + hh]);
                            __syncthreads();
                            const LAS float* kp = kq + cl * 256 + hf * 64; const LAS float* qp = kq + cl * 256 + 128 + hf * 64;
                            float r = 0.f;
#pragma unroll
                            for (int i = 0; i < 64; ++i) r += kp[i] * S[i];
                            part[cl * 256 + hf * 128 + c] = r;
                            __syncthreads();
                            const float rt = part[cl * 256 + c] + part[cl * 256 + 128 + c];
                            const float uu = bt * (vv - a * rt);
                            float o = 0.f;
#pragma unroll
                            for (int i = 0; i < 64; ++i) { S[i] = a * S[i] + kp[i] * uu; o += qp[i] * S[i]; }
                            __syncthreads();
                            part[cl * 256 + hf * 128 + c] = o;
                            __syncthreads();
                            if (want && hf == 0) OUT[(size_t)row * 4096 + hh * 128 + c] = (bf16_t)(pk_bf16(part[cl * 256 + c] + part[cl * 256 + 128 + c], 0.f) & 0xffffu);
                        }
                    }
                }
#else
                scan::gdn_scan(QN, KN, VN, BETA, GG, OF, OB, !last, lds, bid, G, wave);
#endif
                SEAM(pb + 3);
            }
            if (EN(9) && IN(pb + 4)) for (int rep_ = 0; rep_ < NREP(9); ++rep_) { PH_BEGIN_L
                const bf16_t* OF = (const bf16_t*)(ws + WS_OF); const bf16_t* OB = (const bf16_t*)(ws + WS_OB); const bf16_t* Z = (const bf16_t*)(ws + WS_Z); bf16_t* Y = (bf16_t*)(ws + WS_Y);
                const float* gp = ka->in[IN_GGAIN] + j * 128 + (tid & 15) * 8;
                const f32x4 g0 = *(const f32x4*)gp, g1 = *(const f32x4*)(gp + 4);
#define G4_ROW(A_, B_, Z_, off) do { \
                        float o[8] = {bf_lo(A_.x) + bf_lo(B_.x), bf_hi(A_.x) + bf_hi(B_.x), bf_lo(A_.y) + bf_lo(B_.y), bf_hi(A_.y) + bf_hi(B_.y), bf_lo(A_.z) + bf_lo(B_.z), bf_hi(A_.z) + bf_hi(B_.z), bf_lo(A_.w) + bf_lo(B_.w), bf_hi(A_.w) + bf_hi(B_.w)}; \
                        const float zz[8] = {bf_lo(Z_.x), bf_hi(Z_.x), bf_lo(Z_.y), bf_hi(Z_.y), bf_lo(Z_.z), bf_hi(Z_.z), bf_lo(Z_.w), bf_hi(Z_.w)}; \
                        float ss = 0.f; \
                        _Pragma("unroll") for (int e = 0; e < 8; ++e) ss += o[e] * o[e]; \
                        ss = sum16(ss); \
                        const float rs = 1.0f / sqrtf(ss * (1.0f / 128.0f) + EPS); \
                        float y[8]; \
                        _Pragma("unroll") for (int e = 0; e < 8; ++e) y[e] = o[e] * rs * (e < 4 ? g0[e] : g1[e - 4]) * siluf(zz[e]); \
                        u32x4 ov; ov.x = pk_bf16(y[0], y[1]); ov.y = pk_bf16(y[2], y[3]); ov.z = pk_bf16(y[4], y[5]); ov.w = pk_bf16(y[6], y[7]); \
                        *(u32x4*)(Y + (off)) = ov; } while (0)
                const int nfull = (nrows_out / (4 * G)) * (4 * G);
                for (int row = bid; row < nfull; row += 4 * G) {
                    const size_t o0 = (size_t)row * 4096 + tid * 8, o1 = o0 + (size_t)G * 4096, o2 = o1 + (size_t)G * 4096, o3 = o2 + (size_t)G * 4096;
                    const u32x4 a0 = *(const u32x4*)(OF + o0), b0 = *(const u32x4*)(OB + o0), z0 = *(const u32x4*)(Z + o0);
                    const u32x4 a1 = *(const u32x4*)(OF + o1), b1 = *(const u32x4*)(OB + o1), z1 = *(const u32x4*)(Z + o1);
                    const u32x4 a2 = *(const u32x4*)(OF + o2), b2_ = *(const u32x4*)(OB + o2), z2 = *(const u32x4*)(Z + o2);
                    const u32x4 a3 = *(const u32x4*)(OF + o3), b3 = *(const u32x4*)(OB + o3), z3 = *(const u32x4*)(Z + o3);
                    G4_ROW(a0, b0, z0, o0); G4_ROW(a1, b1, z1, o1); G4_ROW(a2, b2_, z2, o2); G4_ROW(a3, b3, z3, o3);
                }
                for (int row = nfull + bid; row < nrows_out; row += G) { const size_t o0 = (size_t)row * 4096 + tid * 8;
                    const u32x4 a0 = *(const u32x4*)(OF + o0), b0 = *(const u32x4*)(OB + o0), z0 = *(const u32x4*)(Z + o0); G4_ROW(a0, b0, z0, o0); }
#undef G4_ROW
                SEAM(pb + 4);
            }
            if (EN(10) && IN(pb + 5)) for (int rep_ = 0; rep_ < NREP(10); ++rep_) { PH_BEGIN_L
                {
                    const bf16_t* Ap = (const bf16_t*)(ws + WS_Y); const bf16_t* Bp = (const bf16_t*)(ws + WS_WOG) + (size_t)j * DM * GDN_VW; const int KK = GDN_VW;
                    pg8::Gemm g{Ap, Bp, NLAT, DM, KK, KK, KK}; pg8::StaticOrder S; S.init(NLAT, DM, G, bid);
                    pg8::EpiResid E{X, modl + 2 * DM};
                    pg8::gemm_phase<pg8::EpiResid, pg8::StaticOrder>(lds, g, S, E, wave);
                    if (nrows_out > NLAT) {
                        for (int sub = bid; sub < 256; sub += G) {
                        const int kq = sub & 3, k128 = KK / 128, kb = (k128 * kq) / 4, ke = (k128 * (kq + 1)) / 4;
                        pg8::Gemm g2{Ap + kb * 128, Bp + kb * 128, NTOK, DM, (ke - kb) * 128, KK, KK}; pg8::TailOrder T{sub};
                        pg8::EpiPartial E2{(float*)(ws + WS_PART) + (size_t)sub * 65536};
                        pg8::gemm_phase<pg8::EpiPartial, pg8::TailOrder>(lds, g2, T, E2, wave); }
                    }
                }
                SEAM(pb + 5);
            }
        }

        if (EN(11) && IN(pb + 6)) for (int rep_ = 0; rep_ < NREP(11); ++rep_) { PH_BEGIN_L norm_mod_phase(nullptr, nullptr, X, false, ka->in[IN_NFFN] + l * DM, modl + 3 * DM, modl + 4 * DM, H, nrows_out, (const float*)(ws + WS_PART), modl + 2 * DM, gw, NGW, lane); SEAM(pb + 6); }
        if (EN(12) && IN(pb + 7)) for (int rep_ = 0; rep_ < NREP(12); ++rep_) { PH_BEGIN_L
            pg8::Gemm g{H, (const bf16_t*)(ws + WS_WUP) + (size_t)l * DFF2 * DM, nrows_out, DFF2, DM, DM, DM}; pg8::StaticOrder S; S.init(nrows_out, DFF2, G, bid);
            pg8::EpiUpAct E{(bf16_t*)(ws + WS_ACT), (bf16_t*)(ws + WS_EDGE), ka->in[IN_FCONV] + (size_t)l * 3 * DFF2, lds + 131072};
            pg8::gemm_phase<pg8::EpiUpAct, pg8::StaticOrder>(lds, g, S, E, wave);
            if (l + 1 < DEPTH) {
                const int nwg_u = (nrows_out / 256) * (DFF2 / 256), rem = nwg_u % G;
                if (bid >= rem) { LAS float* scr = (LAS float*)(lds + wave * 16384); const int gwi = (bid - rem) * NWAVES + wave, ngwi = (G - rem) * NWAVES; const int ln = l + 1;
                    transpose_matrix(ka->in[IN_FUP] + (size_t)ln * DM * DFF2, DM, DFF2, (bf16_t*)(ws + WS_WUP) + (size_t)ln * DFF2 * DM, -1, scr, gwi, ngwi, lane);
                    transpose_matrix(ka->in[IN_FDN] + (size_t)ln * DFF * DM, DFF, DM, (bf16_t*)(ws + WS_WDN) + (size_t)ln * DM * DFF, 0, scr, gwi, ngwi, lane); }
            }
            SEAM(pb + 7);
        }
        if (EN(13) && IN(pb + 8)) for (int rep_ = 0; rep_ < NREP(13); ++rep_) { PH_BEGIN_L
            const bf16_t* EDGE = (const bf16_t*)(ws + WS_EDGE); bf16_t* ACT = (bf16_t*)(ws + WS_ACT);
            const float* cw = ka->in[IN_FCONV] + (size_t)l * 3 * DFF2;
            const int nblk = nrows_out / 64, ntasks = nblk * 2 * 688;
            for (int task = bid * NTHR + tid; task < ntasks; task += G * NTHR) {
                const int cg = task % 688, rest = task / 688, which = rest & 1, blk = rest >> 1;
                const int row = blk * 64 + (which ? 63 : 0), ch0 = cg * 8;
                const int seqlen = row < NLAT ? SEQ : CTXL; const int t = row < NLAT ? (row & (SEQ - 1)) : ((row - NLAT) & (CTXL - 1));
                const size_t pos = (size_t)(ch0 >> 7) * 256 + (ch0 & 127);
                const bf16_t* ecur = EDGE + ((size_t)blk * 4 + (which ? 3 : 0)) * DFF2 + pos;
                const bf16_t* eprev = which ? EDGE + ((size_t)blk * 4 + 2) * DFF2 + pos : EDGE + ((size_t)(blk - 1) * 4 + 3) * DFF2 + pos;
                const bf16_t* enext = which ? EDGE + ((size_t)(blk + 1) * 4 + 0) * DFF2 + pos : EDGE + ((size_t)blk * 4 + 1) * DFF2 + pos;
                const bool okp = t > 0, okn = t + 1 < seqlen;
                const u32x4 z4 = {0u, 0u, 0u, 0u};
                const u32x4 gc = *(const u32x4*)ecur, vc = *(const u32x4*)(ecur + 128);
                const u32x4 gp = okp ? *(const u32x4*)eprev : z4, vp = okp ? *(const u32x4*)(eprev + 128) : z4;
                const u32x4 gn = okn ? *(const u32x4*)enext : z4, vn = okn ? *(const u32x4*)(enext + 128) : z4;
                float wg[3][8], wv[3][8];
#pragma unroll
                for (int k = 0; k < 3; ++k) { const f32x4 a = *(const f32x4*)(cw + (size_t)k * DFF2 + ch0), b2 = *(const f32x4*)(cw + (size_t)k * DFF2 + ch0 + 4);
                    const f32x4 c2 = *(const f32x4*)(cw + (size_t)k * DFF2 + DFF + ch0), d2 = *(const f32x4*)(cw + (size_t)k * DFF2 + DFF + ch0 + 4);
#pragma unroll
                    for (int e = 0; e < 4; ++e) { wg[k][e] = a[e]; wg[k][4 + e] = b2[e]; wv[k][e] = c2[e]; wv[k][4 + e] = d2[e]; } }
#define UNPK8(q, f) do { f[0] = bf_lo(q.x); f[1] = bf_hi(q.x); f[2] = bf_lo(q.y); f[3] = bf_hi(q.y); f[4] = bf_lo(q.z); f[5] = bf_hi(q.z); f[6] = bf_lo(q.w); f[7] = bf_hi(q.w); } while (0)
                float fgp[8], fgc[8], fgn[8], fvp[8], fvc[8], fvn[8];
                UNPK8(gp, fgp); UNPK8(gc, fgc); UNPK8(gn, fgn); UNPK8(vp, fvp); UNPK8(vc, fvc); UNPK8(vn, fvn);
#undef UNPK8
                float y[8];
#pragma unroll
                for (int e = 0; e < 8; ++e) { const float yg = wg[0][e] * fgp[e] + wg[1][e] * fgc[e] + wg[2][e] * fgn[e], yv = wv[0][e] * fvp[e] + wv[1][e] * fvc[e] + wv[2][e] * fvn[e]; y[e] = siluf(yg) * yv; }
                u32x4 ov; ov.x = pk_bf16(y[0], y[1]); ov.y = pk_bf16(y[2], y[3]); ov.z = pk_bf16(y[4], y[5]); ov.w = pk_bf16(y[6], y[7]);
                *(u32x4*)(ACT + (size_t)row * DFF + ch0) = ov;
            }
            SEAM(pb + 8);
        }
        if (EN(14) && IN(pb + 9)) for (int rep_ = 0; rep_ < NREP(14); ++rep_) { PH_BEGIN_L
            {
                    const bf16_t* Ap = (const bf16_t*)(ws + WS_ACT); const bf16_t* Bp = (const bf16_t*)(ws + WS_WDN) + (size_t)l * DM * DFF; const int KK = DFF;
                    pg8::Gemm g{Ap, Bp, NLAT, DM, KK, KK, KK}; pg8::StaticOrder S; S.init(NLAT, DM, G, bid);
                    pg8::EpiResid E{X, modl + 5 * DM};
                    pg8::gemm_phase<pg8::EpiResid, pg8::StaticOrder>(lds, g, S, E, wave);
                    if (nrows_out > NLAT) {
                        for (int sub = bid; sub < 256; sub += G) {
                        const int kq = sub & 3, k128 = KK / 128, kb = (k128 * kq) / 4, ke = (k128 * (kq + 1)) / 4;
                        pg8::Gemm g2{Ap + kb * 128, Bp + kb * 128, NTOK, DM, (ke - kb) * 128, KK, KK}; pg8::TailOrder T{sub};
                        pg8::EpiPartial E2{(float*)(ws + WS_PART) + (size_t)sub * 65536};
                        pg8::gemm_phase<pg8::EpiPartial, pg8::TailOrder>(lds, g2, T, E2, wave); }
                    }
                }
            SEAM(pb + 9);
        }
    }

    if (EN(15) && IN(1 + 10 * DEPTH)) for (int rep_ = 0; rep_ < NREP(15); ++rep_) { PH_BEGIN
        const float* w = ka->in[IN_FNORM];
        for (int row = gw; row < NLAT; row += NGW) {
            const u32x2* xr = (const u32x2*)(X + (size_t)row * DM) + lane; f32x4* op = (f32x4*)(ka->out + (size_t)row * DM) + lane;
            f32x4 v[8]; float s = 0.f;
#pragma unroll
            for (int jj = 0; jj < 8; ++jj) { const u32x2 q = xr[64 * jj]; v[jj] = (f32x4){xs_lo(q.x), xs_hi(q.x), xs_lo(q.y), xs_hi(q.y)}; s += (v[jj][0] * v[jj][0] + v[jj][1] * v[jj][1]) + (v[jj][2] * v[jj][2] + v[jj][3] * v[jj][3]); }
            const float rstd = 1.0f / sqrtf(wave_sum(s) * (1.0f / DM) + EPS);
#pragma unroll
            for (int jj = 0; jj < 8; ++jj) { const f32x4 ww = *((const f32x4*)w + lane + 64 * jj); op[64 * jj] = v[jj] * rstd * ww; }
        }
    }
#undef IN
#undef SEAM
}

constexpr int NPHASES = 2 + 10 * DEPTH;
extern "C" void kernel_launch(void* const* d_in, const int* in_sizes, int n_in, void* d_out, int out_size, void* d_ws, size_t ws_size, hipStream_t stream) {
    static int grid = 0;
    if (grid == 0) {
        if (n_in != 22 || out_size != NLAT * DM || ws_size < WS_END) { fprintf(stderr, "kernel_launch: unexpected shapes: n_in %d out %d ws %zu (need %zu)\n", n_in, out_size, ws_size, (size_t)WS_END); grid = -1; return; }
        int dev = 0, cus = 0, per_cu = 0;
        if (hipGetDevice(&dev) != hipSuccess || hipDeviceGetAttribute(&cus, hipDeviceAttributeMultiprocessorCount, dev) != hipSuccess) { grid = -1; return; }
        if (hipFuncSetAttribute((const void*)fwd, hipFuncAttributeMaxDynamicSharedMemorySize, LDS_BYTES) != hipSuccess) { fprintf(stderr, "kernel_launch: hipFuncSetAttribute failed\n"); grid = -1; return; }
        if (hipOccupancyMaxActiveBlocksPerMultiprocessor(&per_cu, (const void*)fwd, NTHR, LDS_BYTES) != hipSuccess || per_cu < 1) fprintf(stderr, "kernel_launch: occupancy query reports %d\n", per_cu);
        (void)hipGetLastError();
        grid = cus;
    }
    if (grid < 0) return;
    if (hipMemsetAsync((char*)d_ws + WS_CTL, 0, CTL_ZERO_BYTES, stream) != hipSuccess) return;
    Args a{};
    for (int i = 0; i < 22; ++i) a.in[i] = (const float*)d_in[i];
    a.out = (float*)d_out; a.ws = (unsigned char*)d_ws;
#if MK_SINGLE
    a.ph_lo = 0; a.ph_hi = NPHASES; a.li = 0;
    hipLaunchKernelGGL(fwd, dim3(grid), dim3(NTHR), LDS_BYTES, stream, a);
#else
    for (int p = 0; p < NPHASES; ++p) {
        if (p >= 1 && p < 1 + 10 * DEPTH) { const int l = (p - 1) / 10, k = (p - 1) % 10; if (k == 2 && !(l & 1)) continue; }
        a.ph_lo = p; a.ph_hi = p + 1; a.li = 0;
        hipLaunchKernelGGL(fwd, dim3(grid), dim3(NTHR), LDS_BYTES, stream, a);
    }
#endif
    const hipError_t le = hipPeekAtLastError();
    if (le != hipSuccess) fprintf(stderr, "kernel_launch: launch failed: %s\n", hipGetErrorName(le));
}
```
